# Optimizing an MI355X kernel written in HIP

```python
import jax
import jax.numpy as jnp
from jax import lax
import numpy as np


D_MODEL = 2048
BATCH = 4
SEQ = 4096
DEPTH = 1

GRID_W = 64
CTX_LEN = 256
EPS = 1e-6

ATT_HEADS = 16
ATT_KV_HEADS = 4
ATT_GROUP = ATT_HEADS // ATT_KV_HEADS
ATT_HEAD_DIM = 128
ATT_WIDTH = ATT_HEADS * ATT_HEAD_DIM
ATT_KV_WIDTH = ATT_KV_HEADS * ATT_HEAD_DIM
WINDOW = 128
Q_BLOCK = 128
ROPE_BASE = 10000.0

HG_HEADS = 16
HG_EXPAND = 128
HG_HEAD_V = 128
HG_FDIM = HG_HEADS * HG_EXPAND
HG_VDIM = HG_HEADS * HG_HEAD_V
CHUNK = 64
LB_REST_INIT = 1.5

N_BRANCH = 2

OFF_ATT_Q = 0
OFF_ATT_K = OFF_ATT_Q + ATT_WIDTH
OFF_ATT_V = OFF_ATT_K + ATT_KV_WIDTH
OFF_ATT_G = OFF_ATT_V + ATT_KV_WIDTH
OFF_HG_Q = OFF_ATT_G + ATT_WIDTH
OFF_HG_FF = OFF_HG_Q + HG_FDIM
OFF_HG_FB = OFF_HG_FF + HG_FDIM
OFF_HG_I = OFF_HG_FB + HG_FDIM
OFF_HG_G = OFF_HG_I + HG_VDIM
OFF_MERGE = OFF_HG_G + HG_VDIM
IN_COLS = OFF_MERGE + N_BRANCH * D_MODEL

kernel_name = 'hybrid_hgrn2_swa_sink_block'


def rmsnorm(x, gain):
    xf = x.astype(jnp.float32)
    y = xf * lax.rsqrt(jnp.mean(xf * xf, axis=-1, keepdims=True) + EPS)
    return (y * gain.astype(jnp.float32)).astype(x.dtype)


def split_columns(p):
    return (p[..., OFF_ATT_Q:OFF_ATT_K], p[..., OFF_ATT_K:OFF_ATT_V], p[..., OFF_ATT_V:OFF_ATT_G],
            p[..., OFF_ATT_G:OFF_HG_Q], p[..., OFF_HG_Q:OFF_HG_FF], p[..., OFF_HG_FF:OFF_HG_FB],
            p[..., OFF_HG_FB:OFF_HG_I], p[..., OFF_HG_I:OFF_HG_G], p[..., OFF_HG_G:OFF_MERGE],
            p[..., OFF_MERGE:OFF_MERGE + D_MODEL], p[..., OFF_MERGE + D_MODEL:IN_COLS])


def axial_rope_tables(rows, dtype):
    row = jnp.repeat(jnp.arange(rows, dtype=jnp.float32), GRID_W)
    col = jnp.tile(jnp.arange(GRID_W, dtype=jnp.float32), rows)
    half = ATT_HEAD_DIM // 2
    inv_freq = 1.0 / (ROPE_BASE ** (jnp.arange(0, half, 2, dtype=jnp.float32) / half))
    ang_r = row[:, None] * inv_freq[None, :]
    ang_c = col[:, None] * inv_freq[None, :]
    ang = jnp.concatenate([ang_r, ang_r, ang_c, ang_c], axis=-1)
    return jnp.cos(ang).astype(dtype), jnp.sin(ang).astype(dtype)


def apply_axial_rope(x, cos, sin):
    x1, x2, x3, x4 = jnp.split(x, 4, axis=-1)
    rot = jnp.concatenate([-x2, x1, -x4, x3], axis=-1)
    return x * cos[:, None, :] + rot * sin[:, None, :]


def sink_softmax_av(s, v, sink):
    sk = sink.astype(jnp.float32).reshape(ATT_KV_HEADS, ATT_GROUP)[None, :, :, None]
    m = jnp.maximum(jnp.max(s, axis=-1), sk)
    p = jnp.exp(s - m[..., None])
    den = jnp.sum(p, axis=-1) + jnp.exp(sk - m)
    p = (p / den[..., None]).astype(v.dtype)
    return jnp.einsum('bkgqn,bnkd->bqkgd', p, v)


def window_attention(q, k, v, k_ctx, v_ctx, sink):
    B, n = q.shape[0], q.shape[1]
    nb = n // Q_BLOCK
    span = Q_BLOCK + 2 * WINDOW
    qb = q.reshape(B, nb, Q_BLOCK, ATT_KV_HEADS, ATT_GROUP, ATT_HEAD_DIM).transpose(1, 0, 2, 3, 4, 5)
    pad = ((0, 0), (WINDOW, WINDOW), (0, 0), (0, 0))
    kp = jnp.pad(k, pad)
    vp = jnp.pad(v, pad)

    def block(args):
        qn, start = args
        kb = lax.dynamic_slice_in_dim(kp, start, span, axis=1)
        vb = lax.dynamic_slice_in_dim(vp, start, span, axis=1)
        qi = start + jnp.arange(Q_BLOCK)
        kj = start - WINDOW + jnp.arange(span)
        valid = (jnp.abs(qi[:, None] - kj[None, :]) <= WINDOW) & (kj >= 0)[None, :] & (kj < n)[None, :]
        s_lat = jnp.einsum('bqkgd,bskd->bkgqs', qn, kb).astype(jnp.float32)
        s_lat = jnp.where(valid, s_lat, -jnp.inf)
        s_ctx = jnp.einsum('bqkgd,bskd->bkgqs', qn, k_ctx).astype(jnp.float32)
        s = jnp.concatenate([s_lat, s_ctx], axis=-1)
        return sink_softmax_av(s, jnp.concatenate([vb, v_ctx], axis=1), sink)

    out = lax.map(block, (qb, jnp.arange(nb) * Q_BLOCK))
    return out.transpose(1, 0, 2, 3, 4, 5).reshape(B, n, ATT_WIDTH)


def context_attention(q_c, k_c, v_c, sink):
    B, L = q_c.shape[0], q_c.shape[1]
    qg = q_c.reshape(B, L, ATT_KV_HEADS, ATT_GROUP, ATT_HEAD_DIM)
    s = jnp.einsum('bqkgd,bskd->bkgqs', qg, k_c).astype(jnp.float32)
    return sink_softmax_av(s, v_c, sink).reshape(B, L, ATT_WIDTH)


def to_heads(a):
    B, T, _ = a.shape
    return a.reshape(B, T, HG_HEADS, -1).transpose(0, 2, 1, 3)


def hgrn_forget(z, lb):
    lbf = lb[None, None, :]
    f = lbf + (1.0 - lbf) * jax.nn.sigmoid(z.astype(jnp.float32))
    return to_heads(jnp.log(f)), to_heads(1.0 - f)


def hgrn2_scan(q, k, v, logf, s0):
    B, H, T, dk = q.shape
    dv = v.shape[-1]
    nc = T // CHUNK

    def chunks(a):
        return jnp.moveaxis(a.astype(jnp.float32).reshape(B, H, nc, CHUNK, a.shape[-1]), 2, 0)

    causal = jnp.tril(jnp.ones((CHUNK, CHUNK), dtype=bool))

    def step(S, inp):
        qc, kc, vc, gc = inp
        G = jnp.cumsum(gc, axis=2)
        G_end = G[:, :, -1:, :]
        o_inter = jnp.einsum('bhtk,bhkv->bhtv', qc * jnp.exp(G), S)
        diff = G[:, :, :, None, :] - G[:, :, None, :, :]
        decay = jnp.exp(jnp.where(causal[:, :, None], diff, -jnp.inf))
        A = jnp.einsum('bhtk,bhsk,bhtsk->bhts', qc, kc, decay)
        o = o_inter + jnp.einsum('bhts,bhsv->bhtv', A, vc)
        S_new = jnp.exp(G_end[:, :, 0, :, None]) * S + jnp.einsum('bhsk,bhsv->bhkv', kc * jnp.exp(G_end - G), vc)
        return S_new, o

    s_end, o = lax.scan(step, s0.astype(jnp.float32), (chunks(q), chunks(k), chunks(v), chunks(logf)))
    o = jnp.moveaxis(o, 0, 2).reshape(B, H, T, dv)
    return o, s_end


def hgrn2_final_state(k, v, logf):
    G = jnp.cumsum(logf, axis=2)
    w = k.astype(jnp.float32) * jnp.exp(G[:, :, -1:, :] - G)
    return jnp.einsum('bhsk,bhsv->bhkv', w, v.astype(jnp.float32))


def flip_t(a):
    return jnp.flip(a, axis=2)


def hgrn2_bidir(q, v, k_f, g_f, k_b, g_b, s_f, s_b):
    o_f, s_f_end = hgrn2_scan(q, k_f, v, g_f, s_f)
    o_b, s_b_end = hgrn2_scan(flip_t(q), flip_t(k_b), flip_t(v), flip_t(g_b), s_b)
    return o_f + flip_t(o_b), s_f_end, s_b_end


def hgrn_readout(o, gain, gate):
    B, H, T, dv = o.shape
    on = rmsnorm(o.transpose(0, 2, 1, 3), gain.reshape(H, dv)).reshape(B, T, H * dv)
    return on.astype(gate.dtype) * jax.nn.silu(gate)


def merge_and_project(att_branch, hg_branch, m_a, m_b, b_m, w_o_hgrn_l, w_o_attn_l, w_out_l):
    y_a = hg_branch @ w_o_hgrn_l
    y_b = att_branch @ w_o_attn_l
    y = jax.nn.sigmoid(m_a + b_m[0]) * y_a + jax.nn.sigmoid(m_b + b_m[1]) * y_b
    return y @ w_out_l


def setup_inputs(seed: int = 0) -> dict:
    key = jax.random.key(seed)
    ks = jax.random.split(key, 17)
    f32 = jnp.float32
    nrm = lambda k, shape: jax.random.normal(k, shape, dtype=f32)
    return {
        'x': nrm(ks[0], (BATCH, SEQ, D_MODEL)),
        'c': nrm(ks[1], (BATCH, D_MODEL)),
        'ctx': nrm(ks[2], (BATCH, CTX_LEN, D_MODEL)),
        'c_ctx': nrm(ks[3], (D_MODEL,)),
        'w_ada': nrm(ks[4], (DEPTH, D_MODEL, 3 * D_MODEL)) * (0.5 * D_MODEL ** -0.5),
        'b_ada': nrm(ks[5], (DEPTH, 3 * D_MODEL)) * 0.02,
        'norm_gain': 1.0 + 0.02 * nrm(ks[6], (DEPTH, D_MODEL)),
        'w_in': nrm(ks[7], (DEPTH, D_MODEL, IN_COLS)) * D_MODEL ** -0.5,
        'b_merge': nrm(ks[8], (DEPTH, N_BRANCH, D_MODEL)) * 0.02,
        'lb_logits_fwd': (0.1 * nrm(ks[9], (DEPTH + 1, HG_FDIM))).at[-1].add(LB_REST_INIT),
        'lb_logits_bwd': (0.1 * nrm(ks[10], (DEPTH + 1, HG_FDIM))).at[-1].add(LB_REST_INIT),
        'hgrn_norm_gain': 1.0 + 0.02 * nrm(ks[11], (DEPTH, HG_VDIM)),
        'w_o_hgrn': nrm(ks[12], (DEPTH, HG_VDIM, D_MODEL)) * HG_VDIM ** -0.5,
        'sink_logits': nrm(ks[13], (DEPTH, ATT_HEADS)) * 0.5,
        'w_o_attn': nrm(ks[14], (DEPTH, ATT_WIDTH, D_MODEL)) * ATT_WIDTH ** -0.5,
        'w_out': nrm(ks[15], (DEPTH, D_MODEL, D_MODEL)) * D_MODEL ** -0.5,
        'final_norm_gain': 1.0 + 0.02 * nrm(ks[16], (D_MODEL,)),
    }


def reference(x, c, ctx, c_ctx, w_ada, b_ada, norm_gain, w_in, b_merge, lb_logits_fwd, lb_logits_bwd,
              hgrn_norm_gain, w_o_hgrn, sink_logits, w_o_attn, w_out, final_norm_gain):
    B, n, _ = x.shape
    L = ctx.shape[1]
    rows = n // GRID_W
    cos, sin = axial_rope_tables(rows, x.dtype)
    q_scale = ATT_HEAD_DIM ** -0.5
    lb_f_all = jnp.cumsum(jax.nn.softmax(lb_logits_fwd.astype(jnp.float32), axis=0), axis=0)
    lb_b_all = jnp.cumsum(jax.nn.softmax(lb_logits_bwd.astype(jnp.float32), axis=0), axis=0)
    h, hc = x, ctx
    for l in range(DEPTH):
        last = l == DEPTH - 1
        mod = jax.nn.silu(c) @ w_ada[l] + b_ada[l]
        shift, scale, gate = jnp.split(mod[:, None, :], 3, axis=-1)
        mod_c = jax.nn.silu(c_ctx) @ w_ada[l] + b_ada[l]
        shift_c, scale_c, gate_c = jnp.split(mod_c, 3, axis=-1)
        xn = rmsnorm(h, norm_gain[l]) * (1.0 + scale) + shift
        cn = rmsnorm(hc, norm_gain[l]) * (1.0 + scale_c) + shift_c
        aq, ak, av, ag, hq, hff, hfb, hi, hg, ma, mb = split_columns(xn @ w_in[l])
        caq, cak, cav, cag, chq, chff, chfb, chi, chg, cma, cmb = split_columns(cn @ w_in[l])

        q = apply_axial_rope(aq.reshape(B, n, ATT_HEADS, ATT_HEAD_DIM), cos, sin) * q_scale
        k = apply_axial_rope(ak.reshape(B, n, ATT_KV_HEADS, ATT_HEAD_DIM), cos, sin)
        v = av.reshape(B, n, ATT_KV_HEADS, ATT_HEAD_DIM)
        k_c = cak.reshape(B, L, ATT_KV_HEADS, ATT_HEAD_DIM)
        v_c = cav.reshape(B, L, ATT_KV_HEADS, ATT_HEAD_DIM)
        att_branch = window_attention(q, k, v, k_c, v_c, sink_logits[l]) * jax.nn.silu(ag)

        g_f, k_f = hgrn_forget(hff, lb_f_all[l])
        g_b, k_b = hgrn_forget(hfb, lb_b_all[l])
        cg_f, ck_f = hgrn_forget(chff, lb_f_all[l])
        cg_b, ck_b = hgrn_forget(chfb, lb_b_all[l])
        v_h = to_heads(hi)
        cv_h = to_heads(chi)
        q_h = to_heads(jax.nn.silu(hq))
        if last:
            s_f = hgrn2_final_state(ck_f, cv_h, cg_f)
            s_b = hgrn2_final_state(flip_t(ck_b), flip_t(cv_h), flip_t(cg_b))
        else:
            cq_h = to_heads(jax.nn.silu(chq))
            zero = jnp.zeros((B, HG_HEADS, HG_EXPAND, HG_HEAD_V), jnp.float32)
            co, s_f, s_b = hgrn2_bidir(cq_h, cv_h, ck_f, cg_f, ck_b, cg_b, zero, zero)
            c_att = context_attention(caq.reshape(B, L, ATT_HEADS, ATT_HEAD_DIM) * q_scale, k_c, v_c,
                                      sink_logits[l]) * jax.nn.silu(cag)
            c_hg = hgrn_readout(co, hgrn_norm_gain[l], chg)
            hc = hc + gate_c * merge_and_project(c_att, c_hg, cma, cmb, b_merge[l],
                                                 w_o_hgrn[l], w_o_attn[l], w_out[l])
        o, _, _ = hgrn2_bidir(q_h, v_h, k_f, g_f, k_b, g_b, s_f, s_b)
        hg_branch = hgrn_readout(o, hgrn_norm_gain[l], hg)

        h = h + gate * merge_and_project(att_branch, hg_branch, ma, mb, b_merge[l],
                                         w_o_hgrn[l], w_o_attn[l], w_out[l])
    return rmsnorm(h, final_norm_gain)
```

```cpp
#include <hip/hip_runtime.h>
#include <hip/hip_cooperative_groups.h>
#include <cstdio>
#include <cstdint>
namespace cg = cooperative_groups;

#define LAS __attribute__((address_space(3)))
typedef unsigned short u16;
typedef short bf16x8 __attribute__((ext_vector_type(8)));
typedef short s16x4 __attribute__((ext_vector_type(4)));
typedef float f32x2 __attribute__((ext_vector_type(2)));
typedef float f32x4 __attribute__((ext_vector_type(4)));
typedef float f32x16 __attribute__((ext_vector_type(16)));
typedef unsigned u32x2 __attribute__((ext_vector_type(2)));
typedef unsigned u32x4 __attribute__((ext_vector_type(4)));
typedef __bf16 bf2_t __attribute__((ext_vector_type(2)));
typedef _Float16 h2_t __attribute__((ext_vector_type(2)));

constexpr int D = 2048, NB = 4, T = 4096, M = NB * T, LC = 256, MC = NB * LC, MTOT = M + MC;
constexpr int NCOL = 19456, N1 = 11264, N2 = 8192;
constexpr int NMOD = 3 * D;
constexpr float EPS = 1e-6f;
constexpr float LOG2E = 1.4426950408889634f;
constexpr int NTHREADS = 512;
constexpr int LDS_BYTES = 131072 + 4096;
constexpr int LDS_SSB = 131072 + 1024;
constexpr int LDS_CTL = 131072;

constexpr size_t MiB = 1u << 20;
constexpr size_t WS_MOD = 0;
constexpr size_t WS_RSS = 131072;
constexpr size_t WS_QCTR = 200704;
constexpr size_t WS_BAR = 204800;
constexpr size_t CTL_ZERO = 262144;
constexpr size_t WS_WINT = 1 * MiB;
constexpr size_t WS_WH = 77 * MiB, WS_WA = 85 * MiB, WS_WO = 93 * MiB;
constexpr size_t WS_XN = 101 * MiB;
constexpr size_t WS_Q = 169 * MiB;
constexpr size_t WS_K = 233 * MiB;
constexpr size_t WS_VT = 249 * MiB;
constexpr size_t WS_QH = 265 * MiB;
constexpr size_t WS_LFF = 329 * MiB;
constexpr size_t WS_LFB = 393 * MiB;
constexpr size_t WS_VH = 457 * MiB;
constexpr size_t WS_KC = 521 * MiB;
constexpr size_t WS_VCT = 522 * MiB;
constexpr size_t WS_CFF = 523 * MiB, WS_CFB = 527 * MiB, WS_CI = 531 * MiB;
constexpr size_t WS_OB = 535 * MiB;
constexpr size_t WS_END = 599 * MiB;

__device__ __forceinline__ unsigned pk2(float a, float b) { f32x2 v = {a, b}; bf2_t r = __builtin_convertvector(v, bf2_t); return __builtin_bit_cast(unsigned, r); }
__device__ __forceinline__ unsigned pkh2(float a, float b) { f32x2 v = {a, b}; h2_t r = __builtin_convertvector(v, h2_t); return __builtin_bit_cast(unsigned, r); }
__device__ __forceinline__ float bf2f(u16 v) { return __uint_as_float(((unsigned)v) << 16); }
__device__ __forceinline__ float h2f(u16 v) { return (float)__builtin_bit_cast(_Float16, v); }
__device__ __forceinline__ float bflo(unsigned v) { return __uint_as_float(v << 16); }
__device__ __forceinline__ float bfhi(unsigned v) { return __uint_as_float(v & 0xffff0000u); }
__device__ __forceinline__ float fexp2(float x) { return __builtin_amdgcn_exp2f(x); }
__device__ __forceinline__ float sigmoidf_(float x) { return __builtin_amdgcn_rcpf(1.f + fexp2(-x * LOG2E)); }
__device__ __forceinline__ float siluf_(float x) { return x * sigmoidf_(x); }
#define LDS_WAIT() asm volatile("s_waitcnt lgkmcnt(0)" ::: "memory")
#define BAR_LDS() do { asm volatile("s_waitcnt lgkmcnt(0)" ::: "memory"); __builtin_amdgcn_s_barrier(); asm volatile("" ::: "memory"); } while (0)
#define MFMA32(a, b, c) __builtin_amdgcn_mfma_f32_32x32x16_bf16((a), (b), (c), 0, 0, 0)
__device__ __forceinline__ int crow(int reg, int h) { return (reg & 3) + 8 * (reg >> 2) + 4 * h; }

namespace pg8 {
typedef unsigned short bf16_t;
constexpr int BM = 256, BK = 64, HALF = 128, HTB = HALF * BK * 2, STAGE_BYTES = 8 * HTB, NXCD = 8, WGM = 8;
__host__ __device__ __forceinline__ int lds_byte(int r, int c) { const int st = (r >> 4) * 2 + (c >> 5), rr = r & 15, cc = c & 31, ob = rr * 64 + cc * 2; return st * 1024 + (ob ^ (((ob >> 9) & 1) << 5)); }
__host__ __device__ __forceinline__ void stage_rc(int b, int& R, int& C) { const int st = b / 1024, sb = b % 1024, swz = sb ^ (((sb >> 9) & 1) << 5); R = (st >> 1) * 16 + swz / 64; C = (st & 1) * 32 + (swz % 64) / 2; }
__host__ __device__ __forceinline__ int perm32(int rho) { const int n = rho >> 4, i = rho & 15; return 8 * (i >> 2) + 4 * n + (i & 3); }
struct Unit { int pm, pn; };
struct Gemm { const bf16_t* A; const bf16_t* Bt; int M, N, K; };
__device__ __forceinline__ void static_map(int L, int nM, int nN, Unit& u) {
    const int nwg = nM * nN; int wgid = L;
    { const int q = nwg / NXCD, r = nwg % NXCD, xcd = wgid % NXCD, off = wgid / NXCD; wgid = (xcd < r ? xcd * (q + 1) : r * (q + 1) + (xcd - r) * q) + off; }
    const int nig = WGM * nN, gid = wgid / nig, fm = gid * WGM, gsz = (nM - fm) < WGM ? (nM - fm) : WGM;
    u.pm = fm + ((wgid % nig) % gsz); u.pn = (wgid % nig) / gsz;
}
struct StaticOrder {
    int nM, nN, nwg, G, c;
    __device__ void init(int M_, int N_, int G_, int c_) { nM = M_ / BM; nN = N_ / BM; nwg = nM * nN; G = G_; c = c_; }
    __device__ bool next(int i, Unit& u) const { const long L = (long)i * G + c; if (L >= nwg) return false; static_map((int)L, nM, nN, u); return true; }
};
struct Order1 {
    int G, c;
    __device__ bool next(int i, Unit& u) const {
        const long L = (long)i * G + c;
        if (L < 64 * 44) { static_map((int)L, 64, 44, u); return true; }
        if (L < 64 * 44 + 112) { const int idx = (int)L - 64 * 44; u.pm = 64 + (idx & 3); u.pn = idx >> 2; return true; }
        if (L < 64 * 44 + 112 + 144) { static_map((int)L - (64 * 44 + 112), 64, 16, u); u.pn += 60; return true; }
        return false;
    }
};
struct OrderSingle {
    int q;
    __device__ bool next(int i, Unit& u) const { if (i > 0) return false; static_map(q, 64, 16, u); u.pn += 60; return true; }
};

template <class Epi, class Sched, bool ALIGN_EPI = true, bool SP2 = true>
__device__ __forceinline__ void gemm_phase(LAS unsigned char* lds, const Gemm g, const Sched& S, const Epi& E) {
    const int tid = threadIdx.x, wid = __builtin_amdgcn_readfirstlane(tid >> 6), lane = tid & 63, wr = wid >> 2, wc = wid & 3, fr = lane & 15, fq = lane >> 4;
    const int K = g.K, nt = K / BK;
    unsigned voffA[2], voffB[2];
#pragma unroll
    for (int i = 0; i < 2; ++i) { int R, C; stage_rc(tid * 16 + i * 8192, R, C); const int Rb = (R & ~31) + perm32(R & 31);
        voffA[i] = (unsigned)(R * K + C) * 2u; voffB[i] = (unsigned)(Rb * K + C) * 2u; }
    const size_t kstep = (size_t)(BK * 2);
    const int k0r = (int)(((unsigned)__builtin_amdgcn_s_getreg((3 << 11) | 20) & 7u) * (unsigned)(nt >> 3));
#define PG8_KO(t) ((size_t)(((t) + k0r) & (nt - 1)) * kstep)
    const size_t hstep = (size_t)HALF * K * 2;
    const size_t tstep = 2 * hstep;
    const unsigned ldsw = (unsigned)wid * 1024u;
    const int aoff = lds_byte(wr * 64 + fr, fq * 8), boff = lds_byte(wc * 32 + fr, fq * 8);
#define PG8_SA(b, h) (((b) * 2 + (h)) * HTB)
#define PG8_SB(b, h) ((4 + (b) * 2 + (h)) * HTB)
#define PG8_STAGE(bufoff, gbase, voff) do { _Pragma("unroll") for (int _i = 0; _i < 2; ++_i) \
        __builtin_amdgcn_global_load_lds((const unsigned*)((const char*)(gbase) + (voff)[_i]), (LAS unsigned*)(lds + (bufoff) + ldsw + _i * 8192), 16, 0, 0); } while (0)
#define PG8_LDA(dst, b, h) do { _Pragma("unroll") for (int m = 0; m < 4; ++m) _Pragma("unroll") for (int k = 0; k < 2; ++k) dst[m][k] = *(const LAS bf16x8*)(lds + PG8_SA(b, h) + aoff + m * 2048 + k * 1024); } while (0)
#define PG8_LDB(dst, b, h) do { _Pragma("unroll") for (int n = 0; n < 2; ++n) _Pragma("unroll") for (int k = 0; k < 2; ++k) dst[n][k] = *(const LAS bf16x8*)(lds + PG8_SB(b, h) + boff + n * 2048 + k * 1024); } while (0)
#define PG8_MMA(ai, bj, At, Bt) do { __builtin_amdgcn_s_setprio(1); _Pragma("unroll") for (int m = 0; m < 4; ++m) _Pragma("unroll") for (int n = 0; n < 2; ++n) _Pragma("unroll") for (int k = 0; k < 2; ++k) \
        acc[ai][bj][m][n] = __builtin_amdgcn_mfma_f32_16x16x32_bf16(Bt[n][k], At[m][k], acc[ai][bj][m][n], 0, 0, 0); __builtin_amdgcn_s_setprio(0); } while (0)
#define PG8_WAIT_V(n) asm volatile("s_waitcnt vmcnt(" #n ")" ::: "memory")
#define PG8_WAIT_L(n) asm volatile("s_waitcnt lgkmcnt(" #n ")" ::: "memory")
#define PG8_BAR __builtin_amdgcn_s_barrier()
#define PG8_SCHED __builtin_amdgcn_sched_barrier(0)
    Unit cur, nxt; int ui = 0;
    if (!S.next(0, cur)) return;
    f32x4 acc[2][2][4][2];
#pragma unroll
    for (int a = 0; a < 2; ++a)
#pragma unroll
        for (int b = 0; b < 2; ++b)
#pragma unroll
            for (int m = 0; m < 4; ++m)
#pragma unroll
                for (int n = 0; n < 2; ++n) acc[a][b][m][n] = (f32x4){0.f, 0.f, 0.f, 0.f};
    bf16x8 At[4][2], B0[2][2], B1[2][2];
    const char* cA = (const char*)g.A + (size_t)cur.pm * tstep; const char* cB = (const char*)g.Bt + (size_t)cur.pn * tstep;
    if constexpr (SP2) {
        PG8_STAGE(PG8_SB(0, 0), cB + PG8_KO(0), voffB); PG8_STAGE(PG8_SB(0, 1), cB + hstep + PG8_KO(0), voffB); PG8_STAGE(PG8_SA(0, 0), cA + PG8_KO(0), voffA); PG8_STAGE(PG8_SA(0, 1), cA + hstep + PG8_KO(0), voffA);
        if (wr == 1) PG8_BAR;
        PG8_WAIT_V(2); PG8_BAR;
        PG8_STAGE(PG8_SB(1, 0), cB + PG8_KO(1), voffB); PG8_STAGE(PG8_SA(1, 0), cA + PG8_KO(1), voffA); PG8_STAGE(PG8_SB(1, 1), cB + hstep + PG8_KO(1), voffB);
        PG8_WAIT_V(6); PG8_BAR;
    } else {
        PG8_STAGE(PG8_SB(0, 0), cB + PG8_KO(0), voffB); PG8_STAGE(PG8_SA(0, 0), cA + PG8_KO(0), voffA); PG8_STAGE(PG8_SB(0, 1), cB + hstep + PG8_KO(0), voffB); PG8_STAGE(PG8_SA(0, 1), cA + hstep + PG8_KO(0), voffA);
        if (wr == 1) PG8_BAR;
        PG8_WAIT_V(4); PG8_BAR;
        PG8_STAGE(PG8_SB(1, 0), cB + PG8_KO(1), voffB); PG8_STAGE(PG8_SA(1, 0), cA + PG8_KO(1), voffA); PG8_STAGE(PG8_SB(1, 1), cB + hstep + PG8_KO(1), voffB);
        PG8_WAIT_V(6); PG8_BAR;
    }
    for (;;) {
        const bool has_next = S.next(ui + 1, nxt);
        const char* nA = has_next ? (const char*)g.A + (size_t)nxt.pm * tstep : cA; const char* nB = has_next ? (const char*)g.Bt + (size_t)nxt.pn * tstep : cB;
        for (int t = 0; t < nt; t += 2) {
            const bool last = (t == nt - 2);
            const char* a1 = cA + PG8_KO(t + 1);
            const char* a2 = (last ? nA : cA) + PG8_KO(t + 2); const char* b2 = (last ? nB : cB) + PG8_KO(t + 2);
            const char* a3 = (last ? nA : cA) + PG8_KO(t + 3); const char* b3 = (last ? nB : cB) + PG8_KO(t + 3);
            if constexpr (SP2) {
            PG8_LDB(B0, 0, 0); PG8_LDB(B1, 0, 1); PG8_SCHED; PG8_LDA(At, 0, 0); PG8_STAGE(PG8_SA(1, 1), a1 + hstep, voffA);
            PG8_WAIT_V(8); PG8_WAIT_L(0); PG8_BAR; PG8_MMA(0, 0, At, B0); PG8_MMA(0, 1, At, B1); PG8_BAR; PG8_SCHED;
            PG8_LDA(At, 0, 1); PG8_STAGE(PG8_SB(0, 0), b2, voffB); PG8_STAGE(PG8_SB(0, 1), b2 + hstep, voffB); PG8_STAGE(PG8_SA(0, 0), a2, voffA);
            PG8_WAIT_V(8); PG8_WAIT_L(0); PG8_BAR; PG8_MMA(1, 0, At, B0); PG8_MMA(1, 1, At, B1); PG8_BAR; PG8_SCHED;
            PG8_LDB(B0, 1, 0); PG8_LDB(B1, 1, 1); PG8_SCHED; PG8_LDA(At, 1, 0); PG8_STAGE(PG8_SA(0, 1), a2 + hstep, voffA);
            PG8_WAIT_V(8); PG8_WAIT_L(0); PG8_BAR; PG8_MMA(0, 0, At, B0); PG8_MMA(0, 1, At, B1); PG8_BAR; PG8_SCHED;
            PG8_LDA(At, 1, 1); PG8_STAGE(PG8_SB(1, 0), b3, voffB); PG8_STAGE(PG8_SB(1, 1), b3 + hstep, voffB); PG8_STAGE(PG8_SA(1, 0), a3, voffA);
            PG8_WAIT_V(8); PG8_WAIT_L(0); PG8_BAR; PG8_MMA(1, 0, At, B0); PG8_MMA(1, 1, At, B1); PG8_BAR; PG8_SCHED;
            } else {
            PG8_LDB(B0, 0, 0); PG8_SCHED; PG8_LDA(At, 0, 0); PG8_STAGE(PG8_SA(1, 1), a1 + hstep, voffA);
            PG8_WAIT_L(8); PG8_BAR; PG8_WAIT_L(0); PG8_MMA(0, 0, At, B0); PG8_BAR; PG8_SCHED;
            PG8_LDB(B1, 0, 1); PG8_STAGE(PG8_SB(0, 0), b2, voffB);
            PG8_BAR; PG8_WAIT_L(0); PG8_MMA(0, 1, At, B1); PG8_BAR;
            PG8_LDA(At, 0, 1); PG8_STAGE(PG8_SA(0, 0), a2, voffA);
            PG8_BAR; PG8_WAIT_L(0); PG8_MMA(1, 0, At, B0); PG8_BAR; PG8_SCHED;
            PG8_STAGE(PG8_SB(0, 1), b2 + hstep, voffB);
            PG8_WAIT_V(6); PG8_BAR; PG8_MMA(1, 1, At, B1); PG8_BAR;
            PG8_LDB(B0, 1, 0); PG8_SCHED; PG8_LDA(At, 1, 0); PG8_STAGE(PG8_SA(0, 1), a2 + hstep, voffA);
            PG8_WAIT_L(8); PG8_BAR; PG8_WAIT_L(0); PG8_MMA(0, 0, At, B0); PG8_BAR; PG8_SCHED;
            PG8_LDB(B1, 1, 1); PG8_STAGE(PG8_SB(1, 0), b3, voffB);
            PG8_BAR; PG8_WAIT_L(0); PG8_MMA(0, 1, At, B1); PG8_BAR;
            PG8_LDA(At, 1, 1); PG8_STAGE(PG8_SA(1, 0), a3, voffA);
            PG8_BAR; PG8_WAIT_L(0); PG8_MMA(1, 0, At, B0); PG8_BAR; PG8_SCHED;
            PG8_STAGE(PG8_SB(1, 1), b3 + hstep, voffB);
            PG8_WAIT_V(6); PG8_BAR; PG8_MMA(1, 1, At, B1); PG8_BAR;
            }
        }
        if constexpr (ALIGN_EPI) { if (wr == 0) PG8_BAR; }
        E(acc, cur, wr, wc, fr, fq);
        if (!has_next) break;
#pragma unroll
        for (int a = 0; a < 2; ++a)
#pragma unroll
            for (int b = 0; b < 2; ++b)
#pragma unroll
                for (int m = 0; m < 4; ++m)
#pragma unroll
                    for (int n = 0; n < 2; ++n) acc[a][b][m][n] = (f32x4){0.f, 0.f, 0.f, 0.f};
        cur = nxt; cA = nA; cB = nB; ++ui;
        if constexpr (ALIGN_EPI) { if (wr == 1) PG8_BAR; }
    }
    PG8_WAIT_V(0);
    if constexpr (!ALIGN_EPI) { if (wr == 0) PG8_BAR; }
    PG8_BAR;
#undef PG8_KO
#undef PG8_SA
#undef PG8_SB
#undef PG8_STAGE
#undef PG8_LDA
#undef PG8_LDB
#undef PG8_MMA
#undef PG8_WAIT_V
#undef PG8_WAIT_L
#undef PG8_BAR
#undef PG8_SCHED
}
}
using pg8::Unit;
typedef f32x4 AccT[2][2][4][2];

struct Params {
    const float *x, *c, *ctx, *c_ctx, *w_ada, *b_ada, *norm_gain, *w_in, *b_merge, *lb_f, *lb_b, *hg_gain, *w_o_hgrn, *sink, *w_o_attn, *w_out, *fgain;
    float* out; unsigned char* ws;
    int ph_lo, ph_hi;
};

__device__ __forceinline__ int rope_inv(int d) { const int half = d >> 6, dd = d & 63, hi = dd >> 5, r = dd & 31; return ((half * 8 + (r >> 2)) * 8) + hi * 4 + (r & 3); }
__device__ __forceinline__ int dest_row(int c) {
    if (c < 2048) return 7168 + (c & ~127) + rope_inv(c & 127);
    if (c < 2560) { const int cc = c - 2048; return (cc & ~127) + rope_inv(cc & 127); }
    if (c < 3072) return 512 + (c - 2560);
    if (c < 5120) return 11264 + (c - 3072);
    if (c < 7168) return 9216 + (c - 5120);
    if (c < 9216) return 1024 + (c - 7168);
    if (c < 11264) return 3072 + (c - 9216);
    if (c < 13312) return 5120 + (c - 11264);
    return c;
}

__device__ __forceinline__ void transpose_item(const float* W, int K, int N, u16* WT, bool permute, LAS float* scr, int item, int lane) {
    const int nblk = N / 32, kb = item / nblk, nb = item % nblk, k0 = 64 * kb, n0 = 32 * nb;
    float tv[32];
#pragma unroll
    for (int i = 0; i < 32; ++i) { const int kk = 2 * i + (lane >> 5); tv[i] = W[(size_t)(k0 + kk) * N + n0 + (lane & 31)]; }
#pragma unroll
    for (int i = 0; i < 32; ++i) { const int kk = 2 * i + (lane >> 5); scr[kk * 33 + (lane & 31)] = tv[i]; }
    LDS_WAIT();
    const int c = lane & 7;
#pragma unroll
    for (int j = 0; j < 4; ++j) { const int n = (lane >> 3) + 8 * j; const LAS float* s = scr + (8 * c) * 33 + n;
        u32x4 o; o.x = pk2(s[0 * 33], s[1 * 33]); o.y = pk2(s[2 * 33], s[3 * 33]); o.z = pk2(s[4 * 33], s[5 * 33]); o.w = pk2(s[6 * 33], s[7 * 33]);
        const int row = permute ? dest_row(n0 + n) : (n0 + n);
        *(u32x4*)(WT + (size_t)row * K + k0 + 8 * c) = o; }
    LDS_WAIT();
}

__device__ __forceinline__ float wave_sum(float v) {
#pragma unroll
    for (int o = 1; o < 64; o <<= 1) v += __shfl_xor(v, o);
    return v;
}

__device__ __forceinline__ void phase0_mod(const Params& p, int gw, int NGW, int lane) {
    float* mod = (float*)(p.ws + WS_MOD);
    for (int it = gw; it < 64 * 96; it += NGW) {
        const int ks = it / 96, nc = it % 96, k0 = 32 * ks, n = 64 * nc + lane;
        float sv[5];
#pragma unroll
        for (int r = 0; r < 5; ++r) { const float cv = (r < 4) ? p.c[r * D + k0 + (lane & 31)] : p.c_ctx[k0 + (lane & 31)]; sv[r] = siluf_(cv); }
        float acc[5] = {0.f, 0.f, 0.f, 0.f, 0.f};
        const float* wp = p.w_ada + (size_t)k0 * NMOD + n;
#pragma unroll
        for (int kk = 0; kk < 32; ++kk) { const float w = wp[(size_t)kk * NMOD];
#pragma unroll
            for (int r = 0; r < 5; ++r) acc[r] += __shfl(sv[r], kk) * w; }
#pragma unroll
        for (int r = 0; r < 5; ++r) atomicAdd(mod + r * NMOD + n, acc[r]);
    }
}
__device__ __forceinline__ void phase0_tr(const Params& p, LAS unsigned char* lds, int gw, int NGW, int wave, int lane) {
    LAS float* scr = (LAS float*)(lds + wave * 16384);
    constexpr int I_IN = (D / 64) * (NCOL / 32), I_O = (D / 64) * (D / 32);
    for (int it = gw; it < I_IN + 3 * I_O; it += NGW) {
        int r = it;
        if (r < I_IN) { transpose_item(p.w_in, D, NCOL, (u16*)(p.ws + WS_WINT), true, scr, r, lane); continue; } r -= I_IN;
        if (r < I_O) { transpose_item(p.w_o_hgrn, D, D, (u16*)(p.ws + WS_WH), false, scr, r, lane); continue; } r -= I_O;
        if (r < I_O) { transpose_item(p.w_o_attn, D, D, (u16*)(p.ws + WS_WA), false, scr, r, lane); continue; } r -= I_O;
        transpose_item(p.w_out, D, D, (u16*)(p.ws + WS_WO), false, scr, r, lane);
    }
}

__device__ __forceinline__ void phase1(const Params& p, int gw, int NGW, int lane) {
    const float* mod = (const float*)(p.ws + WS_MOD);
    u16* XN = (u16*)(p.ws + WS_XN);
    for (int rowa = gw; rowa < MTOT; rowa += 2 * NGW) {
        const int rowb = (rowa + NGW < MTOT) ? rowa + NGW : rowa;
        const float* srca = (rowa < M) ? p.x + (size_t)rowa * D : p.ctx + (size_t)(rowa - M) * D;
        const float* srcb = (rowb < M) ? p.x + (size_t)rowb * D : p.ctx + (size_t)(rowb - M) * D;
        f32x4 va[8], vb[8]; float sa_ = 0.f, sb_ = 0.f;
#pragma unroll
        for (int j = 0; j < 8; ++j) { va[j] = ((const f32x4*)srca)[lane + 64 * j]; vb[j] = ((const f32x4*)srcb)[lane + 64 * j]; }
#pragma unroll
        for (int j = 0; j < 8; ++j) { sa_ += (va[j].x * va[j].x + va[j].y * va[j].y) + (va[j].z * va[j].z + va[j].w * va[j].w); sb_ += (vb[j].x * vb[j].x + vb[j].y * vb[j].y) + (vb[j].z * vb[j].z + vb[j].w * vb[j].w); }
        const float rsa = __builtin_amdgcn_rsqf(wave_sum(sa_) * (1.f / D) + EPS), rsb = __builtin_amdgcn_rsqf(wave_sum(sb_) * (1.f / D) + EPS);
        const int ra = (rowa < M) ? (rowa / T) : 4, rb = (rowb < M) ? (rowb / T) : 4;
#pragma unroll
        for (int j = 0; j < 8; ++j) {
            const int c = 4 * (lane + 64 * j);
            const f32x4 g = *(const f32x4*)(p.norm_gain + c);
            const f32x4 bsh = *(const f32x4*)(p.b_ada + c), bsc = *(const f32x4*)(p.b_ada + D + c);
            { const f32x4 sh = *(const f32x4*)(mod + ra * NMOD + c) + bsh; const f32x4 sc = *(const f32x4*)(mod + ra * NMOD + D + c) + bsc;
              const f32x4 y = (va[j] * rsa) * g * (sc + 1.f) + sh; u32x2 o; o.x = pk2(y.x, y.y); o.y = pk2(y.z, y.w); *(u32x2*)(XN + (size_t)rowa * D + c) = o; }
            if (rowb != rowa) { const f32x4 sh = *(const f32x4*)(mod + rb * NMOD + c) + bsh; const f32x4 sc = *(const f32x4*)(mod + rb * NMOD + D + c) + bsc;
              const f32x4 y = (vb[j] * rsb) * g * (sc + 1.f) + sh; u32x2 o; o.x = pk2(y.x, y.y); o.y = pk2(y.z, y.w); *(u32x2*)(XN + (size_t)rowb * D + c) = o; }
        }
    }
}

#define EPI_V8(acc, ai, bj, m, v) float v[8]; { const f32x4 _a = acc[ai][bj][m][0], _b = acc[ai][bj][m][1]; v[0] = _a.x; v[1] = _a.y; v[2] = _a.z; v[3] = _a.w; v[4] = _b.x; v[5] = _b.y; v[6] = _b.z; v[7] = _b.w; }
__device__ __forceinline__ u32x4 pack8(const float* v) { u32x4 o; o.x = pk2(v[0], v[1]); o.y = pk2(v[2], v[3]); o.z = pk2(v[4], v[5]); o.w = pk2(v[6], v[7]); return o; }
__device__ __forceinline__ u32x4 pack8h(const float* v) { u32x4 o; o.x = pkh2(v[0], v[1]); o.y = pkh2(v[2], v[3]); o.z = pkh2(v[4], v[5]); o.w = pkh2(v[6], v[7]); return o; }

struct EpiIn {
    unsigned char* ws; const float* lbf; const float* lbb; const float* bm; u16* sg;
    __device__ __forceinline__ void operator()(const AccT& acc, const Unit& u, int wr, int wc, int fr, int fq) const {
        const int pn = u.pn; const bool isctx = u.pm >= 64;
        const int row0 = u.pm * 256 + wr * 64 + fr;
        const int cw = 32 * wc + 8 * fq;
        if (pn >= 60) {
            const int grp = (pn - 60) >> 3; const int colbase = ((pn - 60) & 7) * 256;
            u16* base = sg + (size_t)grp * M * D;
#pragma unroll
            for (int ai = 0; ai < 2; ++ai)
#pragma unroll
                for (int m = 0; m < 4; ++m) {
                    const int row = row0 + 128 * ai + 16 * m;
#pragma unroll
                    for (int bj = 0; bj < 2; ++bj) {
                        EPI_V8(acc, ai, bj, m, v);
                        const int c = colbase + 128 * bj + cw;
                        const float* bp = bm + grp * D + c;
                        const f32x4 b0 = *(const f32x4*)bp, b1 = *(const f32x4*)(bp + 4);
                        v[0] = sigmoidf_(v[0] + b0.x); v[1] = sigmoidf_(v[1] + b0.y); v[2] = sigmoidf_(v[2] + b0.z); v[3] = sigmoidf_(v[3] + b0.w);
                        v[4] = sigmoidf_(v[4] + b1.x); v[5] = sigmoidf_(v[5] + b1.y); v[6] = sigmoidf_(v[6] + b1.z); v[7] = sigmoidf_(v[7] + b1.w);
                        *(u32x4*)(base + (size_t)row * D + c) = pack8(v);
                    }
                }
        } else if (pn < 2 || (pn >= 28 && pn < 36)) {
            const bool isq = pn >= 28;
            const int g = cw >> 3;
            const int axis = g >> 3; const int f0 = (g & 7) * 4;
            float invf[4];
#pragma unroll
            for (int e = 0; e < 4; ++e) invf[e] = fexp2(-(float)(f0 + e) * 0.41524101186092029f) * 0.15915494309189535f;
            const float qs = isq ? (0.08838834764831845f * LOG2E) : 1.f;
            u16* base; int ld, colbase;
            if (isq) { base = (u16*)(ws + WS_Q); ld = D; colbase = (pn - 28) * 256; }
            else if (!isctx) { base = (u16*)(ws + WS_K); ld = 512; colbase = pn * 256; }
            else { base = (u16*)(ws + WS_KC); ld = 512; colbase = pn * 256; }
#pragma unroll
            for (int ai = 0; ai < 2; ++ai)
#pragma unroll
                for (int m = 0; m < 4; ++m) {
                    const int row = row0 + 128 * ai + 16 * m;
                    const int orow = isctx ? row - M : row;
                    const int t = row & (T - 1);
                    const float pos = (float)(axis ? (t & 63) : (t >> 6));
                    float cs[4], sn[4];
#pragma unroll
                    for (int e = 0; e < 4; ++e) { const float rev = pos * invf[e]; cs[e] = isctx ? 1.f : __builtin_amdgcn_cosf(rev); sn[e] = isctx ? 0.f : __builtin_amdgcn_sinf(rev); }
#pragma unroll
                    for (int bj = 0; bj < 2; ++bj) {
                        EPI_V8(acc, ai, bj, m, v);
                        float o[8];
#pragma unroll
                        for (int e = 0; e < 4; ++e) { o[e] = (v[e] * cs[e] - v[4 + e] * sn[e]) * qs; o[4 + e] = (v[4 + e] * cs[e] + v[e] * sn[e]) * qs; }
                        *(u32x4*)(base + (size_t)orow * ld + colbase + 128 * bj + cw) = pack8(o);
                    }
                }
        } else if (pn < 4) {
#pragma unroll
            for (int ai = 0; ai < 2; ++ai)
#pragma unroll
                for (int m = 0; m < 4; ++m) {
                    const int row = row0 + 128 * ai + 16 * m;
#pragma unroll
                    for (int bj = 0; bj < 2; ++bj) {
                        EPI_V8(acc, ai, bj, m, v);
                        const int kvh = (pn - 2) * 2 + bj;
                        u16* dst;
                        if (!isctx) { const int b = row >> 12, t = row & (T - 1); dst = (u16*)(ws + WS_VT) + ((size_t)((b * 4 + kvh) * 128 + cw)) * T + t;
#pragma unroll
                            for (int e = 0; e < 8; ++e) dst[(size_t)e * T] = (u16)(pk2(v[e], 0.f) & 0xffffu);
                        } else { const int rr = row - M, b = rr >> 8, t = rr & (LC - 1); dst = (u16*)(ws + WS_VCT) + ((size_t)((b * 4 + kvh) * 128 + cw)) * LC + t;
#pragma unroll
                            for (int e = 0; e < 8; ++e) dst[(size_t)e * LC] = (u16)(pk2(v[e], 0.f) & 0xffffu);
                        }
                    }
                }
        } else if (pn < 20) {
            const bool bwd = pn >= 12;
            const float* lbl = bwd ? lbb : lbf;
            const int colbase = (pn - (bwd ? 12 : 4)) * 256;
            u16* base = (u16*)(ws + (isctx ? (bwd ? WS_CFB : WS_CFF) : (bwd ? WS_LFB : WS_LFF)));
            float lb[2][8];
#pragma unroll
            for (int bj = 0; bj < 2; ++bj)
#pragma unroll
                for (int e = 0; e < 8; ++e) { const int c = colbase + 128 * bj + cw + e; lb[bj][e] = __builtin_amdgcn_rcpf(1.f + fexp2((lbl[D + c] - lbl[c]) * LOG2E)); }
#pragma unroll
            for (int ai = 0; ai < 2; ++ai)
#pragma unroll
                for (int m = 0; m < 4; ++m) {
                    const int row = row0 + 128 * ai + 16 * m; const int orow = isctx ? row - M : row;
#pragma unroll
                    for (int bj = 0; bj < 2; ++bj) {
                        EPI_V8(acc, ai, bj, m, v);
                        float o[8];
#pragma unroll
                        for (int e = 0; e < 8; ++e) o[e] = (1.f - lb[bj][e]) * sigmoidf_(-v[e]);
                        *(u32x4*)(base + (size_t)orow * D + colbase + 128 * bj + cw) = pack8h(o);
                    }
                }
        } else {
            const bool ishq = pn >= 36;
            const int colbase = (pn - (ishq ? 36 : 20)) * 256;
            u16* base = (u16*)(ws + (ishq ? WS_QH : (isctx ? WS_CI : WS_VH)));
#pragma unroll
            for (int ai = 0; ai < 2; ++ai)
#pragma unroll
                for (int m = 0; m < 4; ++m) {
                    const int row = row0 + 128 * ai + 16 * m; const int orow = isctx ? row - M : row;
#pragma unroll
                    for (int bj = 0; bj < 2; ++bj) {
                        EPI_V8(acc, ai, bj, m, v);
                        if (ishq) {
#pragma unroll
                            for (int e = 0; e < 8; ++e) v[e] = siluf_(v[e]);
                        }
                        *(u32x4*)(base + (size_t)orow * D + colbase + 128 * bj + cw) = pack8(v);
                    }
                }
        }
    }
};

struct EpiGate {
    unsigned char* ws; const float* hgain; LAS unsigned char* lds;
    __device__ __forceinline__ void operator()(const AccT& acc, const Unit& u, int wr, int wc, int fr, int fq) const {
        const int grp = u.pn >> 3; const int colbase = (u.pn & 7) * 256;
        const int row0 = u.pm * 256 + wr * 64 + fr; const int cw = 32 * wc + 8 * fq;
        if (grp == 0) {
            u16* base = (u16*)(ws + WS_Q);
#pragma unroll
            for (int ai = 0; ai < 2; ++ai)
#pragma unroll
                for (int m = 0; m < 4; ++m) {
                    const int row = row0 + 128 * ai + 16 * m;
#pragma unroll
                    for (int bj = 0; bj < 2; ++bj) {
                        EPI_V8(acc, ai, bj, m, v);
                        u16* dst = base + (size_t)row * D + colbase + 128 * bj + cw;
                        const u32x4 in = *(const u32x4*)dst;
                        v[0] = siluf_(v[0]) * bflo(in.x); v[1] = siluf_(v[1]) * bfhi(in.x); v[2] = siluf_(v[2]) * bflo(in.y); v[3] = siluf_(v[3]) * bfhi(in.y);
                        v[4] = siluf_(v[4]) * bflo(in.z); v[5] = siluf_(v[5]) * bfhi(in.z); v[6] = siluf_(v[6]) * bflo(in.w); v[7] = siluf_(v[7]) * bfhi(in.w);
                        *(u32x4*)dst = pack8(v);
                    }
                }
        } else {
            const u16* OFh = (const u16*)(ws + WS_LFF); const u16* OBh = (const u16*)(ws + WS_LFB); u16* OB = (u16*)(ws + WS_OB);
            LAS float* ssb = (LAS float*)(lds + LDS_SSB);
#pragma unroll
            for (int ai = 0; ai < 2; ++ai) {
                unsigned xs[4][2][4];
#pragma unroll
                for (int m = 0; m < 4; ++m)
#pragma unroll
                    for (int bj = 0; bj < 2; ++bj) {
                        const size_t idx = (size_t)(row0 + 128 * ai + 16 * m) * D + colbase + 128 * bj + cw;
                        const u32x4 a = *(const u32x4*)(OFh + idx), b = *(const u32x4*)(OBh + idx);
                        float ss = 0.f;
#pragma unroll
                        for (int e = 0; e < 4; ++e) { const float x0 = h2f((u16)(a[e] & 0xffffu)) + h2f((u16)(b[e] & 0xffffu)), x1 = h2f((u16)(a[e] >> 16)) + h2f((u16)(b[e] >> 16)); ss += x0 * x0 + x1 * x1; xs[m][bj][e] = pkh2(x0, x1); }
                        ss += __shfl_xor(ss, 16); ss += __shfl_xor(ss, 32);
                        if (fq == 0) atomicAdd((float*)(ssb + (128 * ai + 64 * wr + 16 * m + fr) * 2 + bj), ss);
                    }
                BAR_LDS();
#pragma unroll
                for (int m = 0; m < 4; ++m)
#pragma unroll
                    for (int bj = 0; bj < 2; ++bj) {
                        EPI_V8(acc, ai, bj, m, v);
                        const size_t idx = (size_t)(row0 + 128 * ai + 16 * m) * D + colbase + 128 * bj + cw;
                        const float rstd = __builtin_amdgcn_rsqf(ssb[(128 * ai + 64 * wr + 16 * m + fr) * 2 + bj] * (1.f / 128.f) + EPS);
                        const float* gp = hgain + colbase + 128 * bj + cw; const f32x4 ga = *(const f32x4*)gp, gb = *(const f32x4*)(gp + 4);
                        const float g8[8] = {ga.x, ga.y, ga.z, ga.w, gb.x, gb.y, gb.z, gb.w};
#pragma unroll
                        for (int e = 0; e < 4; ++e) { const unsigned xp = xs[m][bj][e]; const float x0 = h2f((u16)(xp & 0xffffu)), x1 = h2f((u16)(xp >> 16));
                            v[2 * e] = siluf_(v[2 * e]) * (x0 * rstd * g8[2 * e]); v[2 * e + 1] = siluf_(v[2 * e + 1]) * (x1 * rstd * g8[2 * e + 1]); }
                        *(u32x4*)(OB + idx) = pack8(v);
                    }
                asm volatile("" ::: "memory");
            }
            BAR_LDS();
            if (fq == 0 && wc == 0) {
#pragma unroll
                for (int ai = 0; ai < 2; ++ai)
#pragma unroll
                    for (int m = 0; m < 4; ++m) { ssb[(128 * ai + 64 * wr + 16 * m + fr) * 2] = 0.f; ssb[(128 * ai + 64 * wr + 16 * m + fr) * 2 + 1] = 0.f; }
            }
        }
    }
};

template <int MODE> struct EpiMerge {
    unsigned char* ws; float* tmp; const u16* sgate;
    __device__ __forceinline__ void operator()(const AccT& acc, const Unit& u, int wr, int wc, int fr, int fq) const {
        const int colbase = u.pn * 256; const int row0 = u.pm * 256 + wr * 64 + fr; const int cw = 32 * wc + 8 * fq;
        const u16* sg = sgate + (size_t)MODE * M * D;
        u16* Y = (u16*)(ws + WS_QH);
#pragma unroll
        for (int ai = 0; ai < 2; ++ai)
#pragma unroll
            for (int m = 0; m < 4; ++m) {
                const int row = row0 + 128 * ai + 16 * m;
#pragma unroll
                for (int bj = 0; bj < 2; ++bj) {
                    EPI_V8(acc, ai, bj, m, v);
                    const size_t idx = (size_t)row * D + colbase + 128 * bj + cw;
                    const u32x4 s = *(const u32x4*)(sg + idx);
                    v[0] *= bflo(s.x); v[1] *= bfhi(s.x); v[2] *= bflo(s.y); v[3] *= bfhi(s.y); v[4] *= bflo(s.z); v[5] *= bfhi(s.z); v[6] *= bflo(s.w); v[7] *= bfhi(s.w);
                    if (MODE == 0) { *(f32x4*)(tmp + idx) = (f32x4){v[0], v[1], v[2], v[3]}; *(f32x4*)(tmp + idx + 4) = (f32x4){v[4], v[5], v[6], v[7]}; }
                    else { const f32x4 t0 = *(const f32x4*)(tmp + idx), t1 = *(const f32x4*)(tmp + idx + 4);
                        v[0] += t0.x; v[1] += t0.y; v[2] += t0.z; v[3] += t0.w; v[4] += t1.x; v[5] += t1.y; v[6] += t1.z; v[7] += t1.w;
                        *(u32x4*)(Y + idx) = pack8(v); }
                }
            }
    }
};

struct EpiOut {
    const float* x; const float* mod; const float* b_ada; float* out; float* rss;
    __device__ __forceinline__ void operator()(const AccT& acc, const Unit& u, int wr, int wc, int fr, int fq) const {
        const int colbase = u.pn * 256; const int row0 = u.pm * 256 + wr * 64 + fr; const int cw = 32 * wc + 8 * fq;
        const int b = u.pm >> 4;
        float gt[2][8];
#pragma unroll
        for (int bj = 0; bj < 2; ++bj)
#pragma unroll
            for (int e = 0; e < 8; ++e) { const int c = colbase + 128 * bj + cw + e; gt[bj][e] = mod[b * NMOD + 2 * D + c] + b_ada[2 * D + c]; }
#pragma unroll
        for (int ai = 0; ai < 2; ++ai)
#pragma unroll
            for (int m = 0; m < 4; ++m) {
                const int row = row0 + 128 * ai + 16 * m; float ss = 0.f;
#pragma unroll
                for (int bj = 0; bj < 2; ++bj) {
                    EPI_V8(acc, ai, bj, m, v);
                    const size_t idx = (size_t)row * D + colbase + 128 * bj + cw;
                    const f32x4 x0 = *(const f32x4*)(x + idx), x1 = *(const f32x4*)(x + idx + 4);
                    f32x4 h0, h1;
                    h0.x = x0.x + gt[bj][0] * v[0]; h0.y = x0.y + gt[bj][1] * v[1]; h0.z = x0.z + gt[bj][2] * v[2]; h0.w = x0.w + gt[bj][3] * v[3];
                    h1.x = x1.x + gt[bj][4] * v[4]; h1.y = x1.y + gt[bj][5] * v[5]; h1.z = x1.z + gt[bj][6] * v[6]; h1.w = x1.w + gt[bj][7] * v[7];
                    ss += (h0.x * h0.x + h0.y * h0.y) + (h0.z * h0.z + h0.w * h0.w) + (h1.x * h1.x + h1.y * h1.y) + (h1.z * h1.z + h1.w * h1.w);
                    *(f32x4*)(out + idx) = h0; *(f32x4*)(out + idx + 4) = h1;
                }
                ss += __shfl_xor(ss, 16); ss += __shfl_xor(ss, 32);
                if (fq == 0) atomicAdd(rss + row, ss);
            }
    }
};

constexpr int AK_LD = 136, AV_LD = 72;
constexpr int ATT_BUF = (64 * AK_LD + 128 * AV_LD) * 2;
__device__ __forceinline__ void attn_unit(const Params& p, LAS unsigned char* lds, int unit, int tid) {
    const int hp = unit & 1, qb = (unit >> 1) & 31, kvh = (unit >> 6) & 3, b = unit >> 8;
    const int wave = tid >> 6, lane = tid & 63, r = lane & 31, h = lane >> 5;
    const int head = kvh * 4 + hp * 2 + (wave >> 2);
    const int tq = qb * 128 + (wave & 3) * 32 + r;
    u16* Q = (u16*)(p.ws + WS_Q);
    const u16* Kb = (const u16*)(p.ws + WS_K); const u16* VTb = (const u16*)(p.ws + WS_VT);
    const u16* KC = (const u16*)(p.ws + WS_KC); const u16* VCT = (const u16*)(p.ws + WS_VCT);
    bf16x8 qf[8];
    { const u16* qp = Q + ((size_t)(b * T + tq)) * D + head * 128 + 8 * h;
#pragma unroll
      for (int s = 0; s < 8; ++s) qf[s] = *(const bf16x8*)(qp + 16 * s); }
    float m_run = p.sink[head] * LOG2E; float l_run = (h == 0) ? 1.f : 0.f;
    f32x16 o[4];
#pragma unroll
    for (int mt = 0; mt < 4; ++mt)
#pragma unroll
        for (int i = 0; i < 16; ++i) o[mt][i] = 0.f;
    const int jb = (qb == 0) ? 2 : 0, je = (qb == 31) ? 4 : 6, nw = je - jb, ntile = nw + 4;
    u32x4 kreg[2], vreg[2];
#define ATT_LOAD(i) do { const int _i = (i); const u16* ks; const u16* vs; size_t vld; \
        if (_i < nw) { const int key0 = qb * 128 - 128 + 64 * (jb + _i); ks = Kb + ((size_t)(b * T + key0)) * 512 + kvh * 128; vs = VTb + ((size_t)((b * 4 + kvh) * 128)) * T + key0; vld = T; } \
        else { const int key0 = 64 * (_i - nw); ks = KC + ((size_t)(b * LC + key0)) * 512 + kvh * 128; vs = VCT + ((size_t)((b * 4 + kvh) * 128)) * LC + key0; vld = LC; } \
        _Pragma("unroll") for (int _j = 0; _j < 2; ++_j) { const int ch = tid + 512 * _j; \
            kreg[_j] = *(const u32x4*)(ks + (size_t)(ch >> 4) * 512 + (ch & 15) * 8); \
            vreg[_j] = *(const u32x4*)(vs + (size_t)(ch >> 3) * vld + (ch & 7) * 8); } } while (0)
#define ATT_STORE(bufi) do { LAS u16* kt = (LAS u16*)(lds + (bufi) * ATT_BUF); LAS u16* vt = kt + 64 * AK_LD; \
        _Pragma("unroll") for (int _j = 0; _j < 2; ++_j) { const int ch = tid + 512 * _j; \
            *(LAS u32x4*)(kt + (ch >> 4) * AK_LD + (ch & 15) * 8) = kreg[_j]; \
            LAS u16* vrow = vt + (ch >> 3) * AV_LD + ((ch & 7) >> 1) * 16 + ((ch & 1) ? 4 : 0);     \
            *(LAS u32x2*)vrow = (u32x2){vreg[_j].x, vreg[_j].y}; *(LAS u32x2*)(vrow + 8) = (u32x2){vreg[_j].z, vreg[_j].w}; } } while (0)
    ATT_LOAD(0); ATT_STORE(0);
    __syncthreads();
    for (int it = 0; it < ntile; ++it) {
        if (it + 1 < ntile) ATT_LOAD(it + 1);
        const LAS u16* kt = (const LAS u16*)(lds + (it & 1) * ATT_BUF); const LAS u16* vt = kt + 64 * AK_LD;
        int cls = 2; int key0 = 0;
        if (it < nw) { key0 = qb * 128 - 128 + 64 * (jb + it); const int q0 = qb * 128 + (wave & 3) * 32;
            if (key0 + 63 < q0 - 128 || key0 > q0 + 31 + 128) cls = 0;
            else if (key0 < q0 + 31 - 128 || key0 + 63 > q0 + 128) cls = 1; }
        if (cls != 0) {
        f32x16 sa[2];
#pragma unroll
        for (int k2 = 0; k2 < 2; ++k2) {
#pragma unroll
            for (int i = 0; i < 16; ++i) sa[k2][i] = 0.f;
#pragma unroll
            for (int s = 0; s < 8; ++s) { const bf16x8 kf = *(const LAS bf16x8*)(kt + (32 * k2 + r) * AK_LD + 16 * s + 8 * h); sa[k2] = MFMA32(kf, qf[s], sa[k2]); }
        }
        if (cls == 1) {
#pragma unroll
            for (int k2 = 0; k2 < 2; ++k2)
#pragma unroll
                for (int i = 0; i < 16; ++i) { const int dk = tq - (key0 + 32 * k2 + crow(i, h)); if (dk > 128 || dk < -128) sa[k2][i] = -INFINITY; }
        }
        float tmax = sa[0][0];
#pragma unroll
        for (int k2 = 0; k2 < 2; ++k2)
#pragma unroll
            for (int i = 0; i < 16; ++i) tmax = fmaxf(tmax, sa[k2][i]);
        tmax = fmaxf(tmax, __shfl_xor(tmax, 32));
        if (__builtin_amdgcn_ballot_w64(tmax > m_run + 8.f) != 0ull) {
            const float m_new = fmaxf(m_run, tmax); const float alpha = fexp2(m_run - m_new); m_run = m_new;
            l_run *= alpha;
#pragma unroll
            for (int mt = 0; mt < 4; ++mt)
#pragma unroll
                for (int i = 0; i < 16; ++i) o[mt][i] *= alpha;
        }
        float lsum = 0.f;
#pragma unroll
        for (int k2 = 0; k2 < 2; ++k2)
#pragma unroll
            for (int i = 0; i < 16; ++i) { const float pe = fexp2(sa[k2][i] - m_run); sa[k2][i] = pe; lsum += pe; }
        l_run += lsum;
#pragma unroll
        for (int k2 = 0; k2 < 2; ++k2)
#pragma unroll
            for (int s2 = 0; s2 < 2; ++s2) {
                u32x4 pk; pk.x = pk2(sa[k2][8 * s2 + 0], sa[k2][8 * s2 + 1]); pk.y = pk2(sa[k2][8 * s2 + 2], sa[k2][8 * s2 + 3]);
                pk.z = pk2(sa[k2][8 * s2 + 4], sa[k2][8 * s2 + 5]); pk.w = pk2(sa[k2][8 * s2 + 6], sa[k2][8 * s2 + 7]);
                const bf16x8 pf = __builtin_bit_cast(bf16x8, pk);
#pragma unroll
                for (int mt = 0; mt < 4; ++mt) {
                    const u32x4 vv = *(const LAS u32x4*)(vt + (32 * mt + r) * AV_LD + 32 * k2 + 16 * s2 + 8 * h);
                    o[mt] = MFMA32(__builtin_bit_cast(bf16x8, vv), pf, o[mt]);
                }
            }
        }
        if (it + 1 < ntile) ATT_STORE((it + 1) & 1);
        __syncthreads();
    }
    const float ltot = l_run + __shfl_xor(l_run, 32); const float inv = 1.f / ltot;
    u16* op = Q + ((size_t)(b * T + tq)) * D + head * 128;
#pragma unroll
    for (int mt = 0; mt < 4; ++mt)
#pragma unroll
        for (int q4 = 0; q4 < 4; ++q4) {
            u32x2 w; w.x = pk2(o[mt][4 * q4 + 0] * inv, o[mt][4 * q4 + 1] * inv); w.y = pk2(o[mt][4 * q4 + 2] * inv, o[mt][4 * q4 + 3] * inv);
            *(u32x2*)(op + 32 * mt + 8 * q4 + 4 * h) = w;
        }
#undef ATT_LOAD
#undef ATT_STORE
}

constexpr int HG_QH_LD = 136, HG_LD = 40;
constexpr int HG_OFF_QH = 0, HG_OFF_KHT = 32 * HG_QH_LD * 2, HG_OFF_VT = HG_OFF_KHT + 128 * HG_LD * 2, HG_OFF_AP = HG_OFF_VT + 128 * HG_LD * 2, HG_OFF_DEC = HG_OFF_AP + 4 * 32 * HG_LD * 2;
constexpr int HG_BUF = HG_OFF_DEC + 512;
constexpr int HG_PRIV = 2 * HG_BUF;
constexpr int NSTEP = 8 + 128;
constexpr int HG_RAW = HG_PRIV + 4 * 2 * 32 * HG_LD * 2, HG_RAW_A = 33 * 64, HG_RAW_W = 3 * HG_RAW_A;
static_assert(HG_RAW + 4 * HG_RAW_W <= LDS_BYTES, "hgrn lds");

__device__ __forceinline__ void hgrn_unit(const Params& p, LAS unsigned char* lds, int unit, int tid) {
    const int dir = unit & 1, hh = (unit >> 1) & 15, b = unit >> 5;
    const int wave = tid >> 6, lane = tid & 63, r = lane & 31, h = lane >> 5;
    const u16* LF = (const u16*)(p.ws + (dir ? WS_LFB : WS_LFF)); const u16* CLF = (const u16*)(p.ws + (dir ? WS_CFB : WS_CFF));
    const u16* QHg = (const u16*)(p.ws + WS_QH); const u16* VHg = (const u16*)(p.ws + WS_VH); const u16* CIg = (const u16*)(p.ws + WS_CI);
    u16* OUTg = (u16*)(p.ws + (dir ? WS_LFB : WS_LFF));
    if (wave >= 4) {
        const int pw = wave - 4;
        LAS u16* QTp = (LAS u16*)(lds + HG_PRIV + pw * (2 * 32 * HG_LD * 2)); LAS u16* KHp = QTp + 32 * HG_LD;
        LAS unsigned char* RAW = lds + HG_RAW + pw * HG_RAW_W;
        const int li = lane >> 2, lc4 = lane & 3;
        const int gcol = hh * 128 + 32 * pw + 8 * lc4;
        u32x4 R0[6], R1[6];
#define HG_LOAD(RS, s) do { const int _s = ((s) < NSTEP) ? (s) : (NSTEP - 1); const bool _ctx = _s < 8; const int _cc = _ctx ? _s : _s - 8; const int _TL = _ctx ? LC : T; \
        const u16* _lf = _ctx ? CLF : LF; const u16* _vs = _ctx ? CIg : VHg; const u16* _qs = _ctx ? CIg : QHg; const unsigned _qm = _ctx ? 0u : 0xffffffffu; \
        _Pragma("unroll") for (int jj = 0; jj < 2; ++jj) { const int pos = 32 * _cc + li + 16 * jj; const int t = dir ? (_TL - 1 - pos) : pos; const size_t idx = ((size_t)(b * _TL + t)) * D + gcol; \
            RS[jj] = *(const u32x4*)(_lf + idx); RS[2 + jj] = *(const u32x4*)(_vs + idx); const u32x4 _q = *(const u32x4*)(_qs + idx); RS[4 + jj] = (u32x4){_q.x & _qm, _q.y & _qm, _q.z & _qm, _q.w & _qm}; } } while (0)
#define HG_BUILD(RS, s) do { const int _sb = (s); \
        LAS unsigned char* buf = lds + (_sb & 1) * HG_BUF; \
        _Pragma("unroll") for (int jj = 0; jj < 2; ++jj) { const int ro = (li + 16 * jj) * 64 + jj * 64 + lc4 * 16; \
            *(LAS u32x4*)(RAW + ro) = RS[jj]; *(LAS u32x4*)(RAW + HG_RAW_A + ro) = RS[2 + jj]; *(LAS u32x4*)(RAW + 2 * HG_RAW_A + ro) = RS[4 + jj]; } \
        LDS_WAIT(); \
        HG_LOAD(RS, _sb + 2); \
        float kkv[16], P[16]; u16 qv[16], vv[16]; float run = 1.f; \
        _Pragma("unroll") for (int ii = 0; ii < 16; ++ii) { const int ro = (16 * h + ii) * 64 + h * 64 + 2 * r; \
            kkv[ii] = h2f(*(const LAS u16*)(RAW + ro)); vv[ii] = *(const LAS u16*)(RAW + HG_RAW_A + ro); qv[ii] = *(const LAS u16*)(RAW + 2 * HG_RAW_A + ro); } \
        _Pragma("unroll") for (int ii = 0; ii < 16; ++ii) { run *= (1.f - kkv[ii]); P[ii] = run; } \
        const float oth = __shfl_xor(run, 32); const float Et = run * oth; const float invE = __builtin_amdgcn_rcpf(Et); \
        const float preoff = h ? oth : 1.f; const float sufoff = h ? 1.f : oth; \
        unsigned khp[8], vpk[8]; float suf = sufoff; \
        _Pragma("unroll") for (int ii = 15; ii >= 0; --ii) { \
            const float q = bf2f(qv[ii]); const float qhv = q * (P[ii] * preoff); const float khv = kkv[ii] * suf; const float qtv = qhv * invE; \
            suf *= (1.f - kkv[ii]); \
            const int i = 16 * h + ii; \
            ((LAS u16*)(buf + HG_OFF_QH))[i * HG_QH_LD + 32 * pw + r] = (u16)(pk2(qhv, 0.f) & 0xffffu); \
            QTp[i * HG_LD + r] = (u16)(pk2(qtv, 0.f) & 0xffffu); \
            const unsigned kb = pk2(khv, 0.f) & 0xffffu; \
            KHp[i * HG_LD + r] = (u16)kb; \
            if (ii & 1) { khp[ii >> 1] = kb << 16; vpk[ii >> 1] = ((unsigned)vv[ii]) << 16; } else { khp[ii >> 1] |= kb; vpk[ii >> 1] |= (unsigned)vv[ii]; } } \
        { LAS u32x4* kd = (LAS u32x4*)((LAS u16*)(buf + HG_OFF_KHT) + (32 * pw + r) * HG_LD + 16 * h); \
          kd[0] = (u32x4){khp[0], khp[1], khp[2], khp[3]}; kd[1] = (u32x4){khp[4], khp[5], khp[6], khp[7]}; \
          LAS u32x4* vd = (LAS u32x4*)((LAS u16*)(buf + HG_OFF_VT) + (32 * pw + r) * HG_LD + 16 * h); \
          vd[0] = (u32x4){vpk[0], vpk[1], vpk[2], vpk[3]}; vd[1] = (u32x4){vpk[4], vpk[5], vpk[6], vpk[7]}; \
          if (h == 0) ((LAS float*)(buf + HG_OFF_DEC))[32 * pw + r] = Et; } \
        LDS_WAIT(); \
        f32x16 a; \
        _Pragma("unroll") for (int i = 0; i < 16; ++i) a[i] = 0.f; \
        _Pragma("unroll") for (int s2 = 0; s2 < 2; ++s2) { const bf16x8 af = *(const LAS bf16x8*)(KHp + r * HG_LD + 16 * s2 + 8 * h); const bf16x8 bfg = *(const LAS bf16x8*)(QTp + r * HG_LD + 16 * s2 + 8 * h); a = MFMA32(af, bfg, a); } \
        LAS u16* ap = (LAS u16*)(buf + HG_OFF_AP) + (pw * 32 + r) * HG_LD; \
        _Pragma("unroll") for (int q4 = 0; q4 < 4; ++q4) { float w[4]; \
            _Pragma("unroll") for (int e = 0; e < 4; ++e) { const int j = 8 * q4 + 4 * h + e; w[e] = (j <= r) ? a[4 * q4 + e] : 0.f; } \
            *(LAS u32x2*)(ap + 8 * q4 + 4 * h) = (u32x2){pk2(w[0], w[1]), pk2(w[2], w[3])}; } } while (0)
        HG_LOAD(R0, 0); HG_LOAD(R1, 1);
        for (int s = 0; s < NSTEP; s += 2) {
            HG_BUILD(R0, s);
            BAR_LDS();
            HG_BUILD(R1, s + 1);
            BAR_LDS();
        }
        BAR_LDS();
#undef HG_LOAD
#undef HG_BUILD
    } else {
        const int n = wave;
        f32x16 S[4];
#pragma unroll
        for (int kt = 0; kt < 4; ++kt)
#pragma unroll
            for (int i = 0; i < 16; ++i) S[kt][i] = 0.f;
        for (int s = 0; s <= NSTEP; ++s) {
            if (s >= 1) {
                const int cs = s - 1;
                const LAS unsigned char* buf = lds + (cs & 1) * HG_BUF;
                const LAS u16* QHs = (const LAS u16*)(buf + HG_OFF_QH); const LAS u16* KHT = (const LAS u16*)(buf + HG_OFF_KHT);
                const LAS u16* VTs = (const LAS u16*)(buf + HG_OFF_VT); const LAS u16* AP = (const LAS u16*)(buf + HG_OFF_AP); const LAS float* DEC = (const LAS float*)(buf + HG_OFF_DEC);
                bf16x8 vf[2], ka[4][2];
#pragma unroll
                for (int s2 = 0; s2 < 2; ++s2) vf[s2] = *(const LAS bf16x8*)(VTs + (32 * n + r) * HG_LD + 16 * s2 + 8 * h);
                if (cs >= 8) {
                    bf16x8 qa[4][2], apf[4][2], sp[4][2];
#pragma unroll
                    for (int kt = 0; kt < 4; ++kt)
#pragma unroll
                        for (int s2 = 0; s2 < 2; ++s2) {
                            const LAS u16* qp = QHs + r * HG_QH_LD + 32 * kt + 16 * s2 + 4 * h;
                            const u32x2 lo = *(const LAS u32x2*)qp, hi = *(const LAS u32x2*)(qp + 8);
                            const u32x4 q4v = {lo.x, lo.y, hi.x, hi.y};
                            qa[kt][s2] = __builtin_bit_cast(bf16x8, q4v);
                            apf[kt][s2] = *(const LAS bf16x8*)(AP + (kt * 32 + r) * HG_LD + 16 * s2 + 8 * h);
                        }
#pragma unroll
                    for (int kt = 0; kt < 4; ++kt)
#pragma unroll
                        for (int s2 = 0; s2 < 2; ++s2) {
                            u32x4 spk; spk.x = pk2(S[kt][8 * s2 + 0], S[kt][8 * s2 + 1]); spk.y = pk2(S[kt][8 * s2 + 2], S[kt][8 * s2 + 3]);
                            spk.z = pk2(S[kt][8 * s2 + 4], S[kt][8 * s2 + 5]); spk.w = pk2(S[kt][8 * s2 + 6], S[kt][8 * s2 + 7]);
                            sp[kt][s2] = __builtin_bit_cast(bf16x8, spk);
                        }
                    f32x16 o1, o2;
#pragma unroll
                    for (int i = 0; i < 16; ++i) { o1[i] = 0.f; o2[i] = 0.f; }
#pragma unroll
                    for (int kt = 0; kt < 4; ++kt)
#pragma unroll
                        for (int s2 = 0; s2 < 2; ++s2) { o1 = MFMA32(qa[kt][s2], sp[kt][s2], o1); o2 = MFMA32(apf[kt][s2], vf[s2], o2); }
#pragma unroll
                    for (int kt = 0; kt < 4; ++kt)
#pragma unroll
                        for (int s2 = 0; s2 < 2; ++s2) ka[kt][s2] = *(const LAS bf16x8*)(KHT + (32 * kt + r) * HG_LD + 16 * s2 + 8 * h);
#pragma unroll
                    for (int kt = 0; kt < 4; ++kt) {
#pragma unroll
                        for (int q4 = 0; q4 < 4; ++q4) { const f32x4 d4 = *(const LAS f32x4*)(DEC + 32 * kt + 8 * q4 + 4 * h);
                            S[kt][4 * q4 + 0] *= d4.x; S[kt][4 * q4 + 1] *= d4.y; S[kt][4 * q4 + 2] *= d4.z; S[kt][4 * q4 + 3] *= d4.w; }
#pragma unroll
                        for (int s2 = 0; s2 < 2; ++s2) S[kt] = MFMA32(ka[kt][s2], vf[s2], S[kt]);
                    }
                    const int cc = cs - 8;
                    if (dir) {
                        u16* ob = OUTg + ((size_t)(b * T + (T - 1 - 32 * cc - 4 * h))) * D + hh * 128 + 32 * n + r;
#pragma unroll
                        for (int i = 0; i < 16; ++i) ob[-(ptrdiff_t)(((i & 3) + 8 * (i >> 2)) * D)] = (u16)(pkh2(o1[i] + o2[i], 0.f) & 0xffffu);
                    } else {
                        u16* of = OUTg + ((size_t)(b * T + 32 * cc + 4 * h)) * D + hh * 128 + 32 * n + r;
#pragma unroll
                        for (int i = 0; i < 16; ++i) of[(size_t)(((i & 3) + 8 * (i >> 2)) * D)] = (u16)(pkh2(o1[i] + o2[i], 0.f) & 0xffffu);
                    }
                } else {
#pragma unroll
                    for (int kt = 0; kt < 4; ++kt)
#pragma unroll
                        for (int s2 = 0; s2 < 2; ++s2) ka[kt][s2] = *(const LAS bf16x8*)(KHT + (32 * kt + r) * HG_LD + 16 * s2 + 8 * h);
#pragma unroll
                    for (int kt = 0; kt < 4; ++kt) {
#pragma unroll
                        for (int q4 = 0; q4 < 4; ++q4) { const f32x4 d4 = *(const LAS f32x4*)(DEC + 32 * kt + 8 * q4 + 4 * h);
                            S[kt][4 * q4 + 0] *= d4.x; S[kt][4 * q4 + 1] *= d4.y; S[kt][4 * q4 + 2] *= d4.z; S[kt][4 * q4 + 3] *= d4.w; }
#pragma unroll
                        for (int s2 = 0; s2 < 2; ++s2) S[kt] = MFMA32(ka[kt][s2], vf[s2], S[kt]);
                    }
                }
            }
            BAR_LDS();
        }
    }
}

__device__ __forceinline__ void phase3b(const Params& p, int gw, int NGW, int lane) {
    const u16* OFh = (const u16*)(p.ws + WS_LFF); const u16* OBh = (const u16*)(p.ws + WS_LFB); u16* OB = (u16*)(p.ws + WS_OB);
    for (int row = gw; row < M; row += NGW) {
#pragma unroll
        for (int j = 0; j < 4; ++j) {
            const int c = 512 * j + 8 * lane; const size_t idx = (size_t)row * D + c;
            const u32x4 aa = *(const u32x4*)(OFh + idx); const u32x4 bb = *(const u32x4*)(OBh + idx);
            float v[8];
#pragma unroll
            for (int e = 0; e < 4; ++e) { const unsigned ua = aa[e], ub = bb[e];
                v[2 * e] = h2f((u16)(ua & 0xffffu)) + h2f((u16)(ub & 0xffffu)); v[2 * e + 1] = h2f((u16)(ua >> 16)) + h2f((u16)(ub >> 16)); }
            float ss = 0.f;
#pragma unroll
            for (int e = 0; e < 8; ++e) ss += v[e] * v[e];
            ss += __shfl_xor(ss, 1); ss += __shfl_xor(ss, 2); ss += __shfl_xor(ss, 4); ss += __shfl_xor(ss, 8);
            const float rstd = __builtin_amdgcn_rsqf(ss * (1.f / 128.f) + EPS);
            const f32x4 g0 = *(const f32x4*)(p.hg_gain + c), g1 = *(const f32x4*)(p.hg_gain + c + 4);
            v[0] *= rstd * g0.x; v[1] *= rstd * g0.y; v[2] *= rstd * g0.z; v[3] *= rstd * g0.w; v[4] *= rstd * g1.x; v[5] *= rstd * g1.y; v[6] *= rstd * g1.z; v[7] *= rstd * g1.w;
            *(u32x4*)(OB + idx) = pack8(v);
        }
    }
}

__device__ __forceinline__ void phase7(const Params& p, int gw, int NGW, int lane) {
    const float* rss = (const float*)(p.ws + WS_RSS);
    f32x4 g[8];
#pragma unroll
    for (int j = 0; j < 8; ++j) g[j] = *((const f32x4*)p.fgain + lane + 64 * j);
    for (int row = gw; row < M; row += 2 * NGW) {
        const int row2 = row + NGW; const bool has2 = row2 < M;
        f32x4* o1 = (f32x4*)(p.out + (size_t)row * D) + lane; f32x4* o2 = (f32x4*)(p.out + (size_t)(has2 ? row2 : row) * D) + lane;
        f32x4 v1[8], v2[8];
#pragma unroll
        for (int j = 0; j < 8; ++j) { v1[j] = o1[64 * j]; v2[j] = o2[64 * j]; }
        const float r1 = __builtin_amdgcn_rsqf(rss[row] * (1.f / D) + EPS), r2 = __builtin_amdgcn_rsqf(rss[has2 ? row2 : row] * (1.f / D) + EPS);
#pragma unroll
        for (int j = 0; j < 8; ++j) o1[64 * j] = v1[j] * r1 * g[j];
        if (has2) {
#pragma unroll
            for (int j = 0; j < 8; ++j) o2[64 * j] = v2[j] * r2 * g[j];
        }
    }
}

#define XB_TMO      128
#define XB_XCNT(j)  (256  + 64 * (j))
#define XB_XSUB(j)  (1280 + 64 * (j))
#define XB_XGEN(j)  (2304 + 64 * (j))
#define XB_TOP      3328
#define XB_TOPGEN   3392
#define XCD_BAR_WORDS 3456
#define XB_SPIN_CAP (1u << 18)
__device__ __forceinline__ unsigned xb_ld(unsigned* p)              { return __hip_atomic_load(p, __ATOMIC_RELAXED, __HIP_MEMORY_SCOPE_AGENT); }
__device__ __forceinline__ unsigned xb_add(unsigned* p, unsigned v) { return __hip_atomic_fetch_add(p, v, __ATOMIC_RELAXED, __HIP_MEMORY_SCOPE_AGENT); }
__device__ __forceinline__ unsigned xb_xcc_id() { return (unsigned)__builtin_amdgcn_s_getreg((3 << 11) | 20) & 0xFu; }
#define XB_SPIN(cond, bar) do { unsigned _sp = 0; while (cond) { __builtin_amdgcn_s_sleep(1); \
    if ((++_sp & 255u) == 0u) { if (xb_ld(&(bar)[XB_TMO])) break; if (_sp > XB_SPIN_CAP) { atomicAdd(&(bar)[XB_TMO], 1u); break; } } } } while (0)
struct XcdBarrier { unsigned* bar; unsigned x; volatile LAS unsigned* st; };
__device__ __forceinline__ XcdBarrier xcd_barrier_post(unsigned* bar, volatile LAS unsigned* st) {
    XcdBarrier b; b.bar = bar; b.x = xb_xcc_id(); b.st = st;
    if (threadIdx.x == 0) (void)xb_add(&bar[XB_XCNT(b.x)], 1u);
    return b;
}
__device__ __forceinline__ void xcd_barrier_complete(unsigned* bar, unsigned x, unsigned& nloc, unsigned& nx) {
    const unsigned G = gridDim.x * gridDim.y * gridDim.z;
    unsigned sum, cnt, mine, sp = 0u;
    for (;;) {
        sum = 0u; cnt = 0u; mine = 0u;
#pragma unroll
        for (unsigned j = 0; j < 16; ++j) { const unsigned c = xb_ld(&bar[XB_XCNT(j)]); sum += c; cnt += (c > 0u) ? 1u : 0u; mine = (j == x) ? c : mine; }
        if (sum == G) break;
        __builtin_amdgcn_s_sleep(1);
        if ((++sp & 255u) == 0u) { if (xb_ld(&bar[XB_TMO])) break; if (sp > XB_SPIN_CAP) { atomicAdd(&bar[XB_TMO], 1u); break; } }
    }
    nloc = mine > 0u ? mine : 1u; nx = cnt > 0u ? cnt : 1u;
}
__device__ __forceinline__ void xcd_barrier(const XcdBarrier& b) {
    asm volatile("s_waitcnt vmcnt(0)" ::: "memory");
    __syncthreads();
    if (threadIdx.x == 0) {
        unsigned* bar = b.bar;
        __builtin_amdgcn_s_waitcnt(0);
        unsigned nloc = b.st[0], nx = b.st[1];
        if (nloc == 0u) { xcd_barrier_complete(bar, b.x, nloc, nx); b.st[0] = nloc; b.st[1] = nx; }
        const unsigned old = xb_add(&bar[XB_XSUB(b.x)], 1u);
        const unsigned gen = old / nloc;
        if (old + 1u == (gen + 1u) * nloc) {
            __builtin_amdgcn_fence(__ATOMIC_RELEASE, "agent");
            asm volatile("s_waitcnt vmcnt(0)" ::: "memory");
            const unsigned og = xb_add(&bar[XB_TOP], 1u);
            const unsigned tg = og / nx;
            if (og + 1u == (tg + 1u) * nx) xb_add(&bar[XB_TOPGEN], 1u);
            else XB_SPIN(xb_ld(&bar[XB_TOPGEN]) == tg, bar);
            __builtin_amdgcn_fence(__ATOMIC_ACQUIRE, "agent");
            xb_add(&bar[XB_XGEN(b.x)], 1u);
            asm volatile("s_waitcnt vmcnt(0)" ::: "memory");
        } else {
            XB_SPIN(xb_ld(&bar[XB_XGEN(b.x)]) == gen, bar);
            __builtin_amdgcn_fence(__ATOMIC_ACQUIRE, "agent");
            asm volatile("s_waitcnt vmcnt(0)" ::: "memory");
        }
    }
    __syncthreads();
}

__global__ void __launch_bounds__(NTHREADS, 2) mega(Params p) {
    extern __shared__ __attribute__((aligned(16))) unsigned char lds_raw[];
    LAS unsigned char* lds = (LAS unsigned char*)lds_raw;
    cg::grid_group grid = cg::this_grid();
    const int tid = threadIdx.x, lane = tid & 63, wave = __builtin_amdgcn_readfirstlane(tid >> 6);
    const int G = gridDim.x, bid = blockIdx.x;
    const int gw = bid * 8 + wave, NGW = G * 8;
    const int lo = p.ph_lo, hi = p.ph_hi;
#define IN(k) (lo <= (k) && (k) < hi)
#define SEAM(k) do { if (IN(k) && IN((k) + 1)) xcd_barrier(xbar); } while (0)
    for (int i = tid; i < (LDS_BYTES - LDS_CTL) / 4; i += NTHREADS) ((LAS unsigned*)(lds + LDS_CTL))[i] = 0u;
    __syncthreads();
    const XcdBarrier xbar = xcd_barrier_post((unsigned*)(p.ws + WS_BAR), (volatile LAS unsigned*)(lds + LDS_CTL + 64));
    if (lo < 0) grid.sync();
    phase0_mod(p, gw, NGW, lane);
    SEAM(0);
    phase0_tr(p, lds, gw, NGW, wave, lane);
    phase1(p, gw, NGW, lane);
    SEAM(1);
    if (IN(2)) {
        pg8::Gemm g{(const u16*)(p.ws + WS_XN), (const u16*)(p.ws + WS_WINT), MTOT, N1, D};
        pg8::Order1 S{G, bid};
        EpiIn E{p.ws, p.lb_f, p.lb_b, p.b_merge, (u16*)p.out};
        pg8::gemm_phase<EpiIn, pg8::Order1>(lds, g, S, E);
    }
    SEAM(2);
    if (IN(3)) {
        if (bid < 128) { for (int u = bid; u < 128; u += (G < 128 ? G : 128)) hgrn_unit(p, lds, u, tid); }
        unsigned* qctr = (unsigned*)(p.ws + WS_QCTR);
        LAS int* sh = (LAS int*)(lds + LDS_CTL);
        int nxtq = 0;
        if (tid == 0) nxtq = (int)atomicAdd(qctr, 1u);
        for (;;) {
            if (tid == 0) sh[0] = nxtq;
            __syncthreads();
            const int pr = sh[0];
            __syncthreads();
            if (pr >= 880 + 1024) break;
            if (tid == 0) nxtq = (int)atomicAdd(qctr, 1u);
            if (pr >= 880) attn_unit(p, lds, pr - 880, tid);
            else {
                pg8::Gemm g{(const u16*)(p.ws + WS_XN), (const u16*)(p.ws + WS_WINT), MTOT, NCOL, D};
                pg8::OrderSingle S{144 + pr};
                EpiIn E{p.ws, p.lb_f, p.lb_b, p.b_merge, (u16*)p.out};
                pg8::gemm_phase<EpiIn, pg8::OrderSingle>(lds, g, S, E);
            }
        }
    }
    SEAM(3);
    if (IN(5)) {
        pg8::Gemm g{(const u16*)(p.ws + WS_XN), (const u16*)(p.ws + WS_WINT) + (size_t)N1 * D, M, 4096, D};
        pg8::StaticOrder S; S.init(M, 4096, G, bid);
        EpiGate E{p.ws, p.hg_gain, lds};
        pg8::gemm_phase<EpiGate, pg8::StaticOrder>(lds, g, S, E);
    }
    SEAM(5);
    if (IN(6)) {
        pg8::StaticOrder S; S.init(M, D, G, bid);
        { pg8::Gemm g{(const u16*)(p.ws + WS_OB), (const u16*)(p.ws + WS_WH), M, D, D}; EpiMerge<0> E{p.ws, (float*)(p.ws + WS_LFF), (const u16*)p.out}; pg8::gemm_phase<EpiMerge<0>, pg8::StaticOrder>(lds, g, S, E); }
        { pg8::Gemm g{(const u16*)(p.ws + WS_Q), (const u16*)(p.ws + WS_WA), M, D, D}; EpiMerge<1> E{p.ws, (float*)(p.ws + WS_LFF), (const u16*)p.out}; pg8::gemm_phase<EpiMerge<1>, pg8::StaticOrder>(lds, g, S, E); }
    }
    SEAM(6);
    if (IN(7)) {
        pg8::StaticOrder S; S.init(M, D, G, bid);
        pg8::Gemm g{(const u16*)(p.ws + WS_QH), (const u16*)(p.ws + WS_WO), M, D, D};
        EpiOut E{p.x, (const float*)(p.ws + WS_MOD), p.b_ada, p.out, (float*)(p.ws + WS_RSS)};
        pg8::gemm_phase<EpiOut, pg8::StaticOrder>(lds, g, S, E);
    }
    SEAM(7);
    if (IN(8)) phase7(p, gw, NGW, lane);
}

#ifndef N_LAUNCH_SPLIT
#define N_LAUNCH_SPLIT 0
#endif
extern "C" void kernel_launch(void* const* d_in, const int* in_sizes, int n_in, void* d_out, int out_size, void* d_ws, size_t ws_size, hipStream_t stream) {
    static int grid = 0;
    if (!grid) {
        int dev = 0, cus = 0, per_cu = 0;
        hipGetDevice(&dev);
        hipDeviceGetAttribute(&cus, hipDeviceAttributeMultiprocessorCount, dev);
        hipFuncSetAttribute((const void*)mega, hipFuncAttributeMaxDynamicSharedMemorySize, LDS_BYTES);
        hipOccupancyMaxActiveBlocksPerMultiprocessor(&per_cu, (const void*)mega, NTHREADS, LDS_BYTES);
        if (per_cu < 1) per_cu = 1;
        grid = cus * 1;
        if (ws_size < WS_END) { fprintf(stderr, "workspace too small: %zu < %zu\n", ws_size, (size_t)WS_END); grid = -1; }
    }
    if (grid <= 0) return;
    Params p{};
    p.x = (const float*)d_in[0]; p.c = (const float*)d_in[1]; p.ctx = (const float*)d_in[2]; p.c_ctx = (const float*)d_in[3];
    p.w_ada = (const float*)d_in[4]; p.b_ada = (const float*)d_in[5]; p.norm_gain = (const float*)d_in[6]; p.w_in = (const float*)d_in[7];
    p.b_merge = (const float*)d_in[8]; p.lb_f = (const float*)d_in[9]; p.lb_b = (const float*)d_in[10]; p.hg_gain = (const float*)d_in[11];
    p.w_o_hgrn = (const float*)d_in[12]; p.sink = (const float*)d_in[13]; p.w_o_attn = (const float*)d_in[14]; p.w_out = (const float*)d_in[15];
    p.fgain = (const float*)d_in[16];
    p.out = (float*)d_out; p.ws = (unsigned char*)d_ws;
    hipMemsetAsync(d_ws, 0, CTL_ZERO, stream);
#if N_LAUNCH_SPLIT
    for (int ph = 0; ph < 9; ++ph) { p.ph_lo = ph; p.ph_hi = ph + 1; hipLaunchKernelGGL(mega, dim3(grid), dim3(NTHREADS), LDS_BYTES, stream, p); }
#else
    p.ph_lo = 0; p.ph_hi = 9;
    void* args[] = {&p};
    hipError_t e = hipLaunchCooperativeKernel((const void*)mega, dim3(grid), dim3(NTHREADS), args, LDS_BYTES, stream);
    if (e != hipSuccess) fprintf(stderr, "cooperative launch failed: %s (grid %d)\n", hipGetErrorString(e), grid);
#endif
}
```

```cpp
#include <hip/hip_runtime.h>
#include <hip/hip_cooperative_groups.h>
#include <cstdio>
#include <cstdint>
namespace cg = cooperative_groups;

#define LAS __attribute__((address_space(3)))
typedef unsigned short u16;
typedef short bf16x8 __attribute__((ext_vector_type(8)));
typedef short s16x4 __attribute__((ext_vector_type(4)));
typedef float f32x2 __attribute__((ext_vector_type(2)));
typedef float f32x4 __attribute__((ext_vector_type(4)));
typedef float f32x16 __attribute__((ext_vector_type(16)));
typedef unsigned u32x2 __attribute__((ext_vector_type(2)));
typedef unsigned u32x4 __attribute__((ext_vector_type(4)));
typedef __bf16 bf2_t __attribute__((ext_vector_type(2)));
typedef _Float16 h2_t __attribute__((ext_vector_type(2)));

constexpr int D = 2048, NB = 4, T = 4096, M = NB * T, LC = 256, MC = NB * LC, MTOT = M + MC;
constexpr int NCOL = 19456, N1 = 11264, N2 = 8192;
constexpr int NMOD = 3 * D;
constexpr float EPS = 1e-6f;
constexpr float LOG2E = 1.4426950408889634f;
constexpr int NTHREADS = 512;
constexpr int LDS_BYTES = 131072 + 4096;
constexpr int LDS_SSB = 131072 + 1024;
constexpr int LDS_CTL = 131072;

constexpr size_t MiB = 1u << 20;
constexpr size_t WS_MOD = 0;
constexpr size_t WS_RSS = 131072;
constexpr size_t WS_QCTR = 200704;
constexpr size_t WS_BAR = 204800;
constexpr size_t CTL_ZERO = 262144;
constexpr size_t WS_WINT = 1 * MiB;
constexpr size_t WS_WH = 77 * MiB, WS_WA = 85 * MiB, WS_WO = 93 * MiB;
constexpr size_t WS_XN = 101 * MiB;
constexpr size_t WS_Q = 169 * MiB;
constexpr size_t WS_K = 233 * MiB;
constexpr size_t WS_VT = 249 * MiB;
constexpr size_t WS_QH = 265 * MiB;
constexpr size_t WS_LFF = 329 * MiB;
constexpr size_t WS_LFB = 393 * MiB;
constexpr size_t WS_VH = 457 * MiB;
constexpr size_t WS_KC = 521 * MiB;
constexpr size_t WS_VCT = 522 * MiB;
constexpr size_t WS_CFF = 523 * MiB, WS_CFB = 527 * MiB, WS_CI = 531 * MiB;
constexpr size_t WS_OB = 535 * MiB;
constexpr size_t WS_END = 599 * MiB;

__device__ __forceinline__ unsigned pk2(float a, float b) { f32x2 v = {a, b}; bf2_t r = __builtin_convertvector(v, bf2_t); return __builtin_bit_cast(unsigned, r); }
__device__ __forceinline__ unsigned pkh2(float a, float b) { f32x2 v = {a, b}; h2_t r = __builtin_convertvector(v, h2_t); return __builtin_bit_cast(unsigned, r); }
__device__ __forceinline__ float bf2f(u16 v) { return __uint_as_float(((unsigned)v) << 16); }
__device__ __forceinline__ float h2f(u16 v) { return (float)__builtin_bit_cast(_Float16, v); }
__device__ __forceinline__ float bflo(unsigned v) { return __uint_as_float(v << 16); }
__device__ __forceinline__ float bfhi(unsigned v) { return __uint_as_float(v & 0xffff0000u); }
__device__ __forceinline__ float fexp2(float x) { return __builtin_amdgcn_exp2f(x); }
__device__ __forceinline__ float sigmoidf_(float x) { return __builtin_amdgcn_rcpf(1.f + fexp2(-x * LOG2E)); }
__device__ __forceinline__ float siluf_(float x) { return x * sigmoidf_(x); }
#define LDS_WAIT() asm volatile("s_waitcnt lgkmcnt(0)" ::: "memory")
#define BAR_LDS() do { asm volatile("s_waitcnt lgkmcnt(0)" ::: "memory"); __builtin_amdgcn_s_barrier(); asm volatile("" ::: "memory"); } while (0)
#define MFMA32(a, b, c) __builtin_amdgcn_mfma_f32_32x32x16_bf16((a), (b), (c), 0, 0, 0)
__device__ __forceinline__ int crow(int reg, int h) { return (reg & 3) + 8 * (reg >> 2) + 4 * h; }

namespace pg8 {
typedef unsigned short bf16_t;
constexpr int BM = 256, BK = 64, HALF = 128, HTB = HALF * BK * 2, STAGE_BYTES = 8 * HTB, NXCD = 8, WGM = 8;
__host__ __device__ __forceinline__ int lds_byte(int r, int c) { const int st = (r >> 4) * 2 + (c >> 5), rr = r & 15, cc = c & 31, ob = rr * 64 + cc * 2; return st * 1024 + (ob ^ (((ob >> 9) & 1) << 5)); }
__host__ __device__ __forceinline__ void stage_rc(int b, int& R, int& C) { const int st = b / 1024, sb = b % 1024, swz = sb ^ (((sb >> 9) & 1) << 5); R = (st >> 1) * 16 + swz / 64; C = (st & 1) * 32 + (swz % 64) / 2; }
__host__ __device__ __forceinline__ int perm32(int rho) { const int n = rho >> 4, i = rho & 15; return 8 * (i >> 2) + 4 * n + (i & 3); }
struct Unit { int pm, pn; };
struct Gemm { const bf16_t* A; const bf16_t* Bt; int M, N, K; };
__device__ __forceinline__ void static_map(int L, int nM, int nN, Unit& u) {
    const int nwg = nM * nN; int wgid = L;
    { const int q = nwg / NXCD, r = nwg % NXCD, xcd = wgid % NXCD, off = wgid / NXCD; wgid = (xcd < r ? xcd * (q + 1) : r * (q + 1) + (xcd - r) * q) + off; }
    const int nig = WGM * nN, gid = wgid / nig, fm = gid * WGM, gsz = (nM - fm) < WGM ? (nM - fm) : WGM;
    u.pm = fm + ((wgid % nig) % gsz); u.pn = (wgid % nig) / gsz;
}
struct StaticOrder {
    int nM, nN, nwg, G, c;
    __device__ void init(int M_, int N_, int G_, int c_) { nM = M_ / BM; nN = N_ / BM; nwg = nM * nN; G = G_; c = c_; }
    __device__ bool next(int i, Unit& u) const { const long L = (long)i * G + c; if (L >= nwg) return false; static_map((int)L, nM, nN, u); return true; }
};
struct Order1 {
    int G, c;
    __device__ bool next(int i, Unit& u) const {
        const long L = (long)i * G + c;
        if (L < 64 * 44) { static_map((int)L, 64, 44, u); return true; }
        if (L < 64 * 44 + 112) { const int idx = (int)L - 64 * 44; u.pm = 64 + (idx & 3); u.pn = idx >> 2; return true; }
        if (L < 64 * 44 + 112 + 144) { static_map((int)L - (64 * 44 + 112), 64, 16, u); u.pn += 60; return true; }
        return false;
    }
};
struct OrderSingle {
    int q;
    __device__ bool next(int i, Unit& u) const { if (i > 0) return false; static_map(q, 64, 16, u); u.pn += 60; return true; }
};

template <class Epi, class Sched, bool ALIGN_EPI = true, bool SP2 = true>
__device__ __forceinline__ void gemm_phase(LAS unsigned char* lds, const Gemm g, const Sched& S, const Epi& E) {
    const int tid = threadIdx.x, wid = __builtin_amdgcn_readfirstlane(tid >> 6), lane = tid & 63, wr = wid >> 2, wc = wid & 3, fr = lane & 15, fq = lane >> 4;
    const int K = g.K, nt = K / BK;
    unsigned voffA[2], voffB[2];
#pragma unroll
    for (int i = 0; i < 2; ++i) { int R, C; stage_rc(tid * 16 + i * 8192, R, C); const int Rb = (R & ~31) + perm32(R & 31);
        voffA[i] = (unsigned)(R * K + C) * 2u; voffB[i] = (unsigned)(Rb * K + C) * 2u; }
    const size_t kstep = (size_t)(BK * 2);
    const int k0r = (int)(((unsigned)__builtin_amdgcn_s_getreg((3 << 11) | 20) & 7u) * (unsigned)(nt >> 3));
#define PG8_KO(t) ((size_t)(((t) + k0r) & (nt - 1)) * kstep)
    const size_t hstep = (size_t)HALF * K * 2;
    const size_t tstep = 2 * hstep;
    const unsigned ldsw = (unsigned)wid * 1024u;
    const int aoff = lds_byte(wr * 64 + fr, fq * 8), boff = lds_byte(wc * 32 + fr, fq * 8);
#define PG8_SA(b, h) (((b) * 2 + (h)) * HTB)
#define PG8_SB(b, h) ((4 + (b) * 2 + (h)) * HTB)
#define PG8_STAGE(bufoff, gbase, voff) do { _Pragma("unroll") for (int _i = 0; _i < 2; ++_i) \
        __builtin_amdgcn_global_load_lds((const unsigned*)((const char*)(gbase) + (voff)[_i]), (LAS unsigned*)(lds + (bufoff) + ldsw + _i * 8192), 16, 0, 0); } while (0)
#define PG8_LDA(dst, b, h) do { _Pragma("unroll") for (int m = 0; m < 4; ++m) _Pragma("unroll") for (int k = 0; k < 2; ++k) dst[m][k] = *(const LAS bf16x8*)(lds + PG8_SA(b, h) + aoff + m * 2048 + k * 1024); } while (0)
#define PG8_LDB(dst, b, h) do { _Pragma("unroll") for (int n = 0; n < 2; ++n) _Pragma("unroll") for (int k = 0; k < 2; ++k) dst[n][k] = *(const LAS bf16x8*)(lds + PG8_SB(b, h) + boff + n * 2048 + k * 1024); } while (0)
#define PG8_MMA(ai, bj, At, Bt) do { __builtin_amdgcn_s_setprio(1); _Pragma("unroll") for (int m = 0; m < 4; ++m) _Pragma("unroll") for (int n = 0; n < 2; ++n) _Pragma("unroll") for (int k = 0; k < 2; ++k) \
        acc[ai][bj][m][n] = __builtin_amdgcn_mfma_f32_16x16x32_bf16(Bt[n][k], At[m][k], acc[ai][bj][m][n], 0, 0, 0); __builtin_amdgcn_s_setprio(0); } while (0)
#define PG8_WAIT_V(n) asm volatile("s_waitcnt vmcnt(" #n ")" ::: "memory")
#define PG8_WAIT_L(n) asm volatile("s_waitcnt lgkmcnt(" #n ")" ::: "memory")
#define PG8_BAR __builtin_amdgcn_s_barrier()
#define PG8_SCHED __builtin_amdgcn_sched_barrier(0)
    Unit cur, nxt; int ui = 0;
    if (!S.next(0, cur)) return;
    f32x4 acc[2][2][4][2];
#pragma unroll
    for (int a = 0; a < 2; ++a)
#pragma unroll
        for (int b = 0; b < 2; ++b)
#pragma unroll
            for (int m = 0; m < 4; ++m)
#pragma unroll
                for (int n = 0; n < 2; ++n) acc[a][b][m][n] = (f32x4){0.f, 0.f, 0.f, 0.f};
    bf16x8 At[4][2], B0[2][2], B1[2][2];
    const char* cA = (const char*)g.A + (size_t)cur.pm * tstep; const char* cB = (const char*)g.Bt + (size_t)cur.pn * tstep;
    if constexpr (SP2) {
        PG8_STAGE(PG8_SB(0, 0), cB + PG8_KO(0), voffB); PG8_STAGE(PG8_SB(0, 1), cB + hstep + PG8_KO(0), voffB); PG8_STAGE(PG8_SA(0, 0), cA + PG8_KO(0), voffA); PG8_STAGE(PG8_SA(0, 1), cA + hstep + PG8_KO(0), voffA);
        if (wr == 1) PG8_BAR;
        PG8_WAIT_V(2); PG8_BAR;
        PG8_STAGE(PG8_SB(1, 0), cB + PG8_KO(1), voffB); PG8_STAGE(PG8_SA(1, 0), cA + PG8_KO(1), voffA); PG8_STAGE(PG8_SB(1, 1), cB + hstep + PG8_KO(1), voffB);
        PG8_WAIT_V(6); PG8_BAR;
    } else {
        PG8_STAGE(PG8_SB(0, 0), cB + PG8_KO(0), voffB); PG8_STAGE(PG8_SA(0, 0), cA + PG8_KO(0), voffA); PG8_STAGE(PG8_SB(0, 1), cB + hstep + PG8_KO(0), voffB); PG8_STAGE(PG8_SA(0, 1), cA + hstep + PG8_KO(0), voffA);
        if (wr == 1) PG8_BAR;
        PG8_WAIT_V(4); PG8_BAR;
        PG8_STAGE(PG8_SB(1, 0), cB + PG8_KO(1), voffB); PG8_STAGE(PG8_SA(1, 0), cA + PG8_KO(1), voffA); PG8_STAGE(PG8_SB(1, 1), cB + hstep + PG8_KO(1), voffB);
        PG8_WAIT_V(6); PG8_BAR;
    }
    for (;;) {
        const bool has_next = S.next(ui + 1, nxt);
        const char* nA = has_next ? (const char*)g.A + (size_t)nxt.pm * tstep : cA; const char* nB = has_next ? (const char*)g.Bt + (size_t)nxt.pn * tstep : cB;
        for (int t = 0; t < nt; t += 2) {
            const bool last = (t == nt - 2);
            const char* a1 = cA + PG8_KO(t + 1);
            const char* a2 = (last ? nA : cA) + PG8_KO(t + 2); const char* b2 = (last ? nB : cB) + PG8_KO(t + 2);
            const char* a3 = (last ? nA : cA) + PG8_KO(t + 3); const char* b3 = (last ? nB : cB) + PG8_KO(t + 3);
            if constexpr (SP2) {
            PG8_LDB(B0, 0, 0); PG8_LDB(B1, 0, 1); PG8_SCHED; PG8_LDA(At, 0, 0); PG8_STAGE(PG8_SA(1, 1), a1 + hstep, voffA);
            PG8_WAIT_V(8); PG8_WAIT_L(0); PG8_BAR; PG8_MMA(0, 0, At, B0); PG8_MMA(0, 1, At, B1); PG8_BAR; PG8_SCHED;
            PG8_LDA(At, 0, 1); PG8_STAGE(PG8_SB(0, 0), b2, voffB); PG8_STAGE(PG8_SB(0, 1), b2 + hstep, voffB); PG8_STAGE(PG8_SA(0, 0), a2, voffA);
            PG8_WAIT_V(8); PG8_WAIT_L(0); PG8_BAR; PG8_MMA(1, 0, At, B0); PG8_MMA(1, 1, At, B1); PG8_BAR; PG8_SCHED;
            PG8_LDB(B0, 1, 0); PG8_LDB(B1, 1, 1); PG8_SCHED; PG8_LDA(At, 1, 0); PG8_STAGE(PG8_SA(0, 1), a2 + hstep, voffA);
            PG8_WAIT_V(8); PG8_WAIT_L(0); PG8_BAR; PG8_MMA(0, 0, At, B0); PG8_MMA(0, 1, At, B1); PG8_BAR; PG8_SCHED;
            PG8_LDA(At, 1, 1); PG8_STAGE(PG8_SB(1, 0), b3, voffB); PG8_STAGE(PG8_SB(1, 1), b3 + hstep, voffB); PG8_STAGE(PG8_SA(1, 0), a3, voffA);
            PG8_WAIT_V(8); PG8_WAIT_L(0); PG8_BAR; PG8_MMA(1, 0, At, B0); PG8_MMA(1, 1, At, B1); PG8_BAR; PG8_SCHED;
            } else {
            PG8_LDB(B0, 0, 0); PG8_SCHED; PG8_LDA(At, 0, 0); PG8_STAGE(PG8_SA(1, 1), a1 + hstep, voffA);
            PG8_WAIT_L(8); PG8_BAR; PG8_WAIT_L(0); PG8_MMA(0, 0, At, B0); PG8_BAR; PG8_SCHED;
            PG8_LDB(B1, 0, 1); PG8_STAGE(PG8_SB(0, 0), b2, voffB);
            PG8_BAR; PG8_WAIT_L(0); PG8_MMA(0, 1, At, B1); PG8_BAR;
            PG8_LDA(At, 0, 1); PG8_STAGE(PG8_SA(0, 0), a2, voffA);
            PG8_BAR; PG8_WAIT_L(0); PG8_MMA(1, 0, At, B0); PG8_BAR; PG8_SCHED;
            PG8_STAGE(PG8_SB(0, 1), b2 + hstep, voffB);
            PG8_WAIT_V(6); PG8_BAR; PG8_MMA(1, 1, At, B1); PG8_BAR;
            PG8_LDB(B0, 1, 0); PG8_SCHED; PG8_LDA(At, 1, 0); PG8_STAGE(PG8_SA(0, 1), a2 + hstep, voffA);
            PG8_WAIT_L(8); PG8_BAR; PG8_WAIT_L(0); PG8_MMA(0, 0, At, B0); PG8_BAR; PG8_SCHED;
            PG8_LDB(B1, 1, 1); PG8_STAGE(PG8_SB(1, 0), b3, voffB);
            PG8_BAR; PG8_WAIT_L(0); PG8_MMA(0, 1, At, B1); PG8_BAR;
            PG8_LDA(At, 1, 1); PG8_STAGE(PG8_SA(1, 0), a3, voffA);
            PG8_BAR; PG8_WAIT_L(0); PG8_MMA(1, 0, At, B0); PG8_BAR; PG8_SCHED;
            PG8_STAGE(PG8_SB(1, 1), b3 + hstep, voffB);
            PG8_WAIT_V(6); PG8_BAR; PG8_MMA(1, 1, At, B1); PG8_BAR;
            }
        }
        if constexpr (ALIGN_EPI) { if (wr == 0) PG8_BAR; }
        E(acc, cur, wr, wc, fr, fq);
        if (!has_next) break;
#pragma unroll
        for (int a = 0; a < 2; ++a)
#pragma unroll
            for (int b = 0; b < 2; ++b)
#pragma unroll
                for (int m = 0; m < 4; ++m)
#pragma unroll
                    for (int n = 0; n < 2; ++n) acc[a][b][m][n] = (f32x4){0.f, 0.f, 0.f, 0.f};
        cur = nxt; cA = nA; cB = nB; ++ui;
        if constexpr (ALIGN_EPI) { if (wr == 1) PG8_BAR; }
    }
    PG8_WAIT_V(0);
    if constexpr (!ALIGN_EPI) { if (wr == 0) PG8_BAR; }
    PG8_BAR;
#undef PG8_KO
#undef PG8_SA
#undef PG8_SB
#undef PG8_STAGE
#undef PG8_LDA
#undef PG8_LDB
#undef PG8_MMA
#undef PG8_WAIT_V
#undef PG8_WAIT_L
#undef PG8_BAR
#undef PG8_SCHED
}
}
using pg8::Unit;
typedef f32x4 AccT[2][2][4][2];

struct Params {
    const float *x, *c, *ctx, *c_ctx, *w_ada, *b_ada, *norm_gain, *w_in, *b_merge, *lb_f, *lb_b, *hg_gain, *w_o_hgrn, *sink, *w_o_attn, *w_out, *fgain;
    float* out; unsigned char* ws;
    int ph_lo, ph_hi;
};

__device__ __forceinline__ int rope_inv(int d) { const int half = d >> 6, dd = d & 63, hi = dd >> 5, r = dd & 31; return ((half * 8 + (r >> 2)) * 8) + hi * 4 + (r & 3); }
__device__ __forceinline__ int dest_row(int c) {
    if (c < 2048) return 7168 + (c & ~127) + rope_inv(c & 127);
    if (c < 2560) { const int cc = c - 2048; return (cc & ~127) + rope_inv(cc & 127); }
    if (c < 3072) return 512 + (c - 2560);
    if (c < 5120) return 11264 + (c - 3072);
    if (c < 7168) return 9216 + (c - 5120);
    if (c < 9216) return 1024 + (c - 7168);
    if (c < 11264) return 3072 + (c - 9216);
    if (c < 13312) return 5120 + (c - 11264);
    return c;
}

__device__ __forceinline__ void transpose_item(const float* W, int K, int N, u16* WT, bool permute, LAS float* scr, int item, int lane) {
    const int nblk = N / 32, kb = item / nblk, nb = item % nblk, k0 = 64 * kb, n0 = 32 * nb;
    float tv[32];
#pragma unroll
    for (int i = 0; i < 32; ++i) { const int kk = 2 * i + (lane >> 5); tv[i] = W[(size_t)(k0 + kk) * N + n0 + (lane & 31)]; }
#pragma unroll
    for (int i = 0; i < 32; ++i) { const int kk = 2 * i + (lane >> 5); scr[kk * 33 + (lane & 31)] = tv[i]; }
    LDS_WAIT();
    const int c = lane & 7;
#pragma unroll
    for (int j = 0; j < 4; ++j) { const int n = (lane >> 3) + 8 * j; const LAS float* s = scr + (8 * c) * 33 + n;
        u32x4 o; o.x = pk2(s[0 * 33], s[1 * 33]); o.y = pk2(s[2 * 33], s[3 * 33]); o.z = pk2(s[4 * 33], s[5 * 33]); o.w = pk2(s[6 * 33], s[7 * 33]);
        const int row = permute ? dest_row(n0 + n) : (n0 + n);
        *(u32x4*)(WT + (size_t)row * K + k0 + 8 * c) = o; }
    LDS_WAIT();
}

__device__ __forceinline__ float wave_sum(float v) {
#pragma unroll
    for (int o = 1; o < 64; o <<= 1) v += __shfl_xor(v, o);
    return v;
}

__device__ __forceinline__ void phase0_mod(const Params& p, int gw, int NGW, int lane) {
    float* mod = (float*)(p.ws + WS_MOD);
    for (int it = gw; it < 64 * 96; it += NGW) {
        const int ks = it / 96, nc = it % 96, k0 = 32 * ks, n = 64 * nc + lane;
        float sv[5];
#pragma unroll
        for (int r = 0; r < 5; ++r) { const float cv = (r < 4) ? p.c[r * D + k0 + (lane & 31)] : p.c_ctx[k0 + (lane & 31)]; sv[r] = siluf_(cv); }
        float acc[5] = {0.f, 0.f, 0.f, 0.f, 0.f};
        const float* wp = p.w_ada + (size_t)k0 * NMOD + n;
#pragma unroll
        for (int kk = 0; kk < 32; ++kk) { const float w = wp[(size_t)kk * NMOD];
#pragma unroll
            for (int r = 0; r < 5; ++r) acc[r] += __shfl(sv[r], kk) * w; }
#pragma unroll
        for (int r = 0; r < 5; ++r) atomicAdd(mod + r * NMOD + n, acc[r]);
    }
}
__device__ __forceinline__ void phase0_tr(const Params& p, LAS unsigned char* lds, int gw, int NGW, int wave, int lane) {
    LAS float* scr = (LAS float*)(lds + wave * 16384);
    constexpr int I_IN = (D / 64) * (NCOL / 32), I_O = (D / 64) * (D / 32);
    for (int it = gw; it < I_IN + 3 * I_O; it += NGW) {
        int r = it;
        if (r < I_IN) { transpose_item(p.w_in, D, NCOL, (u16*)(p.ws + WS_WINT), true, scr, r, lane); continue; } r -= I_IN;
        if (r < I_O) { transpose_item(p.w_o_hgrn, D, D, (u16*)(p.ws + WS_WH), false, scr, r, lane); continue; } r -= I_O;
        if (r < I_O) { transpose_item(p.w_o_attn, D, D, (u16*)(p.ws + WS_WA), false, scr, r, lane); continue; } r -= I_O;
        transpose_item(p.w_out, D, D, (u16*)(p.ws + WS_WO), false, scr, r, lane);
    }
}

__device__ __forceinline__ void phase1(const Params& p, int gw, int NGW, int lane) {
    const float* mod = (const float*)(p.ws + WS_MOD);
    u16* XN = (u16*)(p.ws + WS_XN);
    for (int rowa = gw; rowa < MTOT; rowa += 2 * NGW) {
        const int rowb = (rowa + NGW < MTOT) ? rowa + NGW : rowa;
        const float* srca = (rowa < M) ? p.x + (size_t)rowa * D : p.ctx + (size_t)(rowa - M) * D;
        const float* srcb = (rowb < M) ? p.x + (size_t)rowb * D : p.ctx + (size_t)(rowb - M) * D;
        f32x4 va[8], vb[8]; float sa_ = 0.f, sb_ = 0.f;
#pragma unroll
        for (int j = 0; j < 8; ++j) { va[j] = ((const f32x4*)srca)[lane + 64 * j]; vb[j] = ((const f32x4*)srcb)[lane + 64 * j]; }
#pragma unroll
        for (int j = 0; j < 8; ++j) { sa_ += (va[j].x * va[j].x + va[j].y * va[j].y) + (va[j].z * va[j].z + va[j].w * va[j].w); sb_ += (vb[j].x * vb[j].x + vb[j].y * vb[j].y) + (vb[j].z * vb[j].z + vb[j].w * vb[j].w); }
        const float rsa = __builtin_amdgcn_rsqf(wave_sum(sa_) * (1.f / D) + EPS), rsb = __builtin_amdgcn_rsqf(wave_sum(sb_) * (1.f / D) + EPS);
        const int ra = (rowa < M) ? (rowa / T) : 4, rb = (rowb < M) ? (rowb / T) : 4;
#pragma unroll
        for (int j = 0; j < 8; ++j) {
            const int c = 4 * (lane + 64 * j);
            const f32x4 g = *(const f32x4*)(p.norm_gain + c);
            const f32x4 bsh = *(const f32x4*)(p.b_ada + c), bsc = *(const f32x4*)(p.b_ada + D + c);
            { const f32x4 sh = *(const f32x4*)(mod + ra * NMOD + c) + bsh; const f32x4 sc = *(const f32x4*)(mod + ra * NMOD + D + c) + bsc;
              const f32x4 y = (va[j] * rsa) * g * (sc + 1.f) + sh; u32x2 o; o.x = pk2(y.x, y.y); o.y = pk2(y.z, y.w); *(u32x2*)(XN + (size_t)rowa * D + c) = o; }
            if (rowb != rowa) { const f32x4 sh = *(const f32x4*)(mod + rb * NMOD + c) + bsh; const f32x4 sc = *(const f32x4*)(mod + rb * NMOD + D + c) + bsc;
              const f32x4 y = (vb[j] * rsb) * g * (sc + 1.f) + sh; u32x2 o; o.x = pk2(y.x, y.y); o.y = pk2(y.z, y.w); *(u32x2*)(XN + (size_t)rowb * D + c) = o; }
        }
    }
}

#define EPI_V8(acc, ai, bj, m, v) float v[8]; { const f32x4 _a = acc[ai][bj][m][0], _b = acc[ai][bj][m][1]; v[0] = _a.x; v[1] = _a.y; v[2] = _a.z; v[3] = _a.w; v[4] = _b.x; v[5] = _b.y; v[6] = _b.z; v[7] = _b.w; }
__device__ __forceinline__ u32x4 pack8(const float* v) { u32x4 o; o.x = pk2(v[0], v[1]); o.y = pk2(v[2], v[3]); o.z = pk2(v[4], v[5]); o.w = pk2(v[6], v[7]); return o; }
__device__ __forceinline__ u32x4 pack8h(const float* v) { u32x4 o; o.x = pkh2(v[0], v[1]); o.y = pkh2(v[2], v[3]); o.z = pkh2(v[4], v[5]); o.w = pkh2(v[6], v[7]); return o; }

struct EpiIn {
    unsigned char* ws; const float* lbf; const float* lbb; const float* bm; u16* sg;
    __device__ __forceinline__ void operator()(const AccT& acc, const Unit& u, int wr, int wc, int fr, int fq) const {
        const int pn = u.pn; const bool isctx = u.pm >= 64;
        const int row0 = u.pm * 256 + wr * 64 + fr;
        const int cw = 32 * wc + 8 * fq;
        if (pn >= 60) {
            const int grp = (pn - 60) >> 3; const int colbase = ((pn - 60) & 7) * 256;
            u16* base = sg + (size_t)grp * M * D;
#pragma unroll
            for (int ai = 0; ai < 2; ++ai)
#pragma unroll
                for (int m = 0; m < 4; ++m) {
                    const int row = row0 + 128 * ai + 16 * m;
#pragma unroll
                    for (int bj = 0; bj < 2; ++bj) {
                        EPI_V8(acc, ai, bj, m, v);
                        const int c = colbase + 128 * bj + cw;
                        const float* bp = bm + grp * D + c;
                        const f32x4 b0 = *(const f32x4*)bp, b1 = *(const f32x4*)(bp + 4);
                        v[0] = sigmoidf_(v[0] + b0.x); v[1] = sigmoidf_(v[1] + b0.y); v[2] = sigmoidf_(v[2] + b0.z); v[3] = sigmoidf_(v[3] + b0.w);
                        v[4] = sigmoidf_(v[4] + b1.x); v[5] = sigmoidf_(v[5] + b1.y); v[6] = sigmoidf_(v[6] + b1.z); v[7] = sigmoidf_(v[7] + b1.w);
                        *(u32x4*)(base + (size_t)row * D + c) = pack8(v);
                    }
                }
        } else if (pn < 2 || (pn >= 28 && pn < 36)) {
            const bool isq = pn >= 28;
            const int g = cw >> 3;
            const int axis = g >> 3; const int f0 = (g & 7) * 4;
            float invf[4];
#pragma unroll
            for (int e = 0; e < 4; ++e) invf[e] = fexp2(-(float)(f0 + e) * 0.41524101186092029f) * 0.15915494309189535f;
            const float qs = isq ? (0.08838834764831845f * LOG2E) : 1.f;
            u16* base; int ld, colbase;
            if (isq) { base = (u16*)(ws + WS_Q); ld = D; colbase = (pn - 28) * 256; }
            else if (!isctx) { base = (u16*)(ws + WS_K); ld = 512; colbase = pn * 256; }
            else { base = (u16*)(ws + WS_KC); ld = 512; colbase = pn * 256; }
#pragma unroll
            for (int ai = 0; ai < 2; ++ai)
#pragma unroll
                for (int m = 0; m < 4; ++m) {
                    const int row = row0 + 128 * ai + 16 * m;
                    const int orow = isctx ? row - M : row;
                    const int t = row & (T - 1);
                    const float pos = (float)(axis ? (t & 63) : (t >> 6));
                    float cs[4], sn[4];
#pragma unroll
                    for (int e = 0; e < 4; ++e) { const float rev = pos * invf[e]; cs[e] = isctx ? 1.f : __builtin_amdgcn_cosf(rev); sn[e] = isctx ? 0.f : __builtin_amdgcn_sinf(rev); }
#pragma unroll
                    for (int bj = 0; bj < 2; ++bj) {
                        EPI_V8(acc, ai, bj, m, v);
                        float o[8];
#pragma unroll
                        for (int e = 0; e < 4; ++e) { o[e] = (v[e] * cs[e] - v[4 + e] * sn[e]) * qs; o[4 + e] = (v[4 + e] * cs[e] + v[e] * sn[e]) * qs; }
                        *(u32x4*)(base + (size_t)orow * ld + colbase + 128 * bj + cw) = pack8(o);
                    }
                }
        } else if (pn < 4) {
#pragma unroll
            for (int ai = 0; ai < 2; ++ai)
#pragma unroll
                for (int m = 0; m < 4; ++m) {
                    const int row = row0 + 128 * ai + 16 * m;
#pragma unroll
                    for (int bj = 0; bj < 2; ++bj) {
                        EPI_V8(acc, ai, bj, m, v);
                        const int kvh = (pn - 2) * 2 + bj;
                        u16* dst;
                        if (!isctx) { const int b = row >> 12, t = row & (T - 1); dst = (u16*)(ws + WS_VT) + ((size_t)((b * 4 + kvh) * 128 + cw)) * T + t;
#pragma unroll
                            for (int e = 0; e < 8; ++e) dst[(size_t)e * T] = (u16)(pk2(v[e], 0.f) & 0xffffu);
                        } else { const int rr = row - M, b = rr >> 8, t = rr & (LC - 1); dst = (u16*)(ws + WS_VCT) + ((size_t)((b * 4 + kvh) * 128 + cw)) * LC + t;
#pragma unroll
                            for (int e = 0; e < 8; ++e) dst[(size_t)e * LC] = (u16)(pk2(v[e], 0.f) & 0xffffu);
                        }
                    }
                }
        } else if (pn < 20) {
            const bool bwd = pn >= 12;
            const float* lbl = bwd ? lbb : lbf;
            const int colbase = (pn - (bwd ? 12 : 4)) * 256;
            u16* base = (u16*)(ws + (isctx ? (bwd ? WS_CFB : WS_CFF) : (bwd ? WS_LFB : WS_LFF)));
            float lb[2][8];
#pragma unroll
            for (int bj = 0; bj < 2; ++bj)
#pragma unroll
                for (int e = 0; e < 8; ++e) { const int c = colbase + 128 * bj + cw + e; lb[bj][e] = __builtin_amdgcn_rcpf(1.f + fexp2((lbl[D + c] - lbl[c]) * LOG2E)); }
#pragma unroll
            for (int ai = 0; ai < 2; ++ai)
#pragma unroll
                for (int m = 0; m < 4; ++m) {
                    const int row = row0 + 128 * ai + 16 * m; const int orow = isctx ? row - M : row;
#pragma unroll
                    for (int bj = 0; bj < 2; ++bj) {
                        EPI_V8(acc, ai, bj, m, v);
                        float o[8];
#pragma unroll
                        for (int e = 0; e < 8; ++e) o[e] = (1.f - lb[bj][e]) * sigmoidf_(-v[e]);
                        *(u32x4*)(base + (size_t)orow * D + colbase + 128 * bj + cw) = pack8h(o);
                    }
                }
        } else {
            const bool ishq = pn >= 36;
            const int colbase = (pn - (ishq ? 36 : 20)) * 256;
            u16* base = (u16*)(ws + (ishq ? WS_QH : (isctx ? WS_CI : WS_VH)));
#pragma unroll
            for (int ai = 0; ai < 2; ++ai)
#pragma unroll
                for (int m = 0; m < 4; ++m) {
                    const int row = row0 + 128 * ai + 16 * m; const int orow = isctx ? row - M : row;
#pragma unroll
                    for (int bj = 0; bj < 2; ++bj) {
                        EPI_V8(acc, ai, bj, m, v);
                        if (ishq) {
#pragma unroll
                            for (int e = 0; e < 8; ++e) v[e] = siluf_(v[e]);
                        }
                        *(u32x4*)(base + (size_t)orow * D + colbase + 128 * bj + cw) = pack8(v);
                    }
                }
        }
    }
};

struct EpiGate {
    unsigned char* ws; const float* hgain; LAS unsigned char* lds;
    __device__ __forceinline__ void operator()(const AccT& acc, const Unit& u, int wr, int wc, int fr, int fq) const {
        const int grp = u.pn >> 3; const int colbase = (u.pn & 7) * 256;
        const int row0 = u.pm * 256 + wr * 64 + fr; const int cw = 32 * wc + 8 * fq;
        if (grp == 0) {
            u16* base = (u16*)(ws + WS_Q);
#pragma unroll
            for (int ai = 0; ai < 2; ++ai)
#pragma unroll
                for (int m = 0; m < 4; ++m) {
                    const int row = row0 + 128 * ai + 16 * m;
#pragma unroll
                    for (int bj = 0; bj < 2; ++bj) {
                        EPI_V8(acc, ai, bj, m, v);
                        u16* dst = base + (size_t)row * D + colbase + 128 * bj + cw;
                        const u32x4 in = *(const u32x4*)dst;
                        v[0] = siluf_(v[0]) * bflo(in.x); v[1] = siluf_(v[1]) * bfhi(in.x); v[2] = siluf_(v[2]) * bflo(in.y); v[3] = siluf_(v[3]) * bfhi(in.y);
                        v[4] = siluf_(v[4]) * bflo(in.z); v[5] = siluf_(v[5]) * bfhi(in.z); v[6] = siluf_(v[6]) * bflo(in.w); v[7] = siluf_(v[7]) * bfhi(in.w);
                        *(u32x4*)dst = pack8(v);
                    }
                }
        } else {
            const u16* OFh = (const u16*)(ws + WS_LFF); const u16* OBh = (const u16*)(ws + WS_LFB); u16* OB = (u16*)(ws + WS_OB);
            LAS float* ssb = (LAS float*)(lds + LDS_SSB);
#pragma unroll
            for (int ai = 0; ai < 2; ++ai) {
                unsigned xs[4][2][4];
#pragma unroll
                for (int m = 0; m < 4; ++m)
#pragma unroll
                    for (int bj = 0; bj < 2; ++bj) {
                        const size_t idx = (size_t)(row0 + 128 * ai + 16 * m) * D + colbase + 128 * bj + cw;
                        const u32x4 a = *(const u32x4*)(OFh + idx), b = *(const u32x4*)(OBh + idx);
                        float ss = 0.f;
#pragma unroll
                        for (int e = 0; e < 4; ++e) { const float x0 = h2f((u16)(a[e] & 0xffffu)) + h2f((u16)(b[e] & 0xffffu)), x1 = h2f((u16)(a[e] >> 16)) + h2f((u16)(b[e] >> 16)); ss += x0 * x0 + x1 * x1; xs[m][bj][e] = pkh2(x0, x1); }
                        ss += __shfl_xor(ss, 16); ss += __shfl_xor(ss, 32);
                        if (fq == 0) atomicAdd((float*)(ssb + (128 * ai + 64 * wr + 16 * m + fr) * 2 + bj), ss);
                    }
                BAR_LDS();
#pragma unroll
                for (int m = 0; m < 4; ++m)
#pragma unroll
                    for (int bj = 0; bj < 2; ++bj) {
                        EPI_V8(acc, ai, bj, m, v);
                        const size_t idx = (size_t)(row0 + 128 * ai + 16 * m) * D + colbase + 128 * bj + cw;
                        const float rstd = __builtin_amdgcn_rsqf(ssb[(128 * ai + 64 * wr + 16 * m + fr) * 2 + bj] * (1.f / 128.f) + EPS);
                        const float* gp = hgain + colbase + 128 * bj + cw; const f32x4 ga = *(const f32x4*)gp, gb = *(const f32x4*)(gp + 4);
                        const float g8[8] = {ga.x, ga.y, ga.z, ga.w, gb.x, gb.y, gb.z, gb.w};
#pragma unroll
                        for (int e = 0; e < 4; ++e) { const unsigned xp = xs[m][bj][e]; const float x0 = h2f((u16)(xp & 0xffffu)), x1 = h2f((u16)(xp >> 16));
                            v[2 * e] = siluf_(v[2 * e]) * (x0 * rstd * g8[2 * e]); v[2 * e + 1] = siluf_(v[2 * e + 1]) * (x1 * rstd * g8[2 * e + 1]); }
                        *(u32x4*)(OB + idx) = pack8(v);
                    }
                asm volatile("" ::: "memory");
            }
            BAR_LDS();
            if (fq == 0 && wc == 0) {
#pragma unroll
                for (int ai = 0; ai < 2; ++ai)
#pragma unroll
                    for (int m = 0; m < 4; ++m) { ssb[(128 * ai + 64 * wr + 16 * m + fr) * 2] = 0.f; ssb[(128 * ai + 64 * wr + 16 * m + fr) * 2 + 1] = 0.f; }
            }
        }
    }
};

template <int MODE> struct EpiMerge {
    unsigned char* ws; float* tmp; const u16* sgate;
    __device__ __forceinline__ void operator()(const AccT& acc, const Unit& u, int wr, int wc, int fr, int fq) const {
        const int colbase = u.pn * 256; const int row0 = u.pm * 256 + wr * 64 + fr; const int cw = 32 * wc + 8 * fq;
        const u16* sg = sgate + (size_t)MODE * M * D;
        u16* Y = (u16*)(ws + WS_QH);
#pragma unroll
        for (int ai = 0; ai < 2; ++ai)
#pragma unroll
            for (int m = 0; m < 4; ++m) {
                const int row = row0 + 128 * ai + 16 * m;
#pragma unroll
                for (int bj = 0; bj < 2; ++bj) {
                    EPI_V8(acc, ai, bj, m, v);
                    const size_t idx = (size_t)row * D + colbase + 128 * bj + cw;
                    const u32x4 s = *(const u32x4*)(sg + idx);
                    v[0] *= bflo(s.x); v[1] *= bfhi(s.x); v[2] *= bflo(s.y); v[3] *= bfhi(s.y); v[4] *= bflo(s.z); v[5] *= bfhi(s.z); v[6] *= bflo(s.w); v[7] *= bfhi(s.w);
                    if (MODE == 0) { *(f32x4*)(tmp + idx) = (f32x4){v[0], v[1], v[2], v[3]}; *(f32x4*)(tmp + idx + 4) = (f32x4){v[4], v[5], v[6], v[7]}; }
                    else { const f32x4 t0 = *(const f32x4*)(tmp + idx), t1 = *(const f32x4*)(tmp + idx + 4);
                        v[0] += t0.x; v[1] += t0.y; v[2] += t0.z; v[3] += t0.w; v[4] += t1.x; v[5] += t1.y; v[6] += t1.z; v[7] += t1.w;
                        *(u32x4*)(Y + idx) = pack8(v); }
                }
            }
    }
};

struct EpiOut {
    const float* x; const float* mod; const float* b_ada; float* out; float* rss;
    __device__ __forceinline__ void operator()(const AccT& acc, const Unit& u, int wr, int wc, int fr, int fq) const {
        const int colbase = u.pn * 256; const int row0 = u.pm * 256 + wr * 64 + fr; const int cw = 32 * wc + 8 * fq;
        const int b = u.pm >> 4;
        float gt[2][8];
#pragma unroll
        for (int bj = 0; bj < 2; ++bj)
#pragma unroll
            for (int e = 0; e < 8; ++e) { const int c = colbase + 128 * bj + cw + e; gt[bj][e] = mod[b * NMOD + 2 * D + c] + b_ada[2 * D + c]; }
#pragma unroll
        for (int ai = 0; ai < 2; ++ai)
#pragma unroll
            for (int m = 0; m < 4; ++m) {
                const int row = row0 + 128 * ai + 16 * m; float ss = 0.f;
#pragma unroll
                for (int bj = 0; bj < 2; ++bj) {
                    EPI_V8(acc, ai, bj, m, v);
                    const size_t idx = (size_t)row * D + colbase + 128 * bj + cw;
                    const f32x4 x0 = *(const f32x4*)(x + idx), x1 = *(const f32x4*)(x + idx + 4);
                    f32x4 h0, h1;
                    h0.x = x0.x + gt[bj][0] * v[0]; h0.y = x0.y + gt[bj][1] * v[1]; h0.z = x0.z + gt[bj][2] * v[2]; h0.w = x0.w + gt[bj][3] * v[3];
                    h1.x = x1.x + gt[bj][4] * v[4]; h1.y = x1.y + gt[bj][5] * v[5]; h1.z = x1.z + gt[bj][6] * v[6]; h1.w = x1.w + gt[bj][7] * v[7];
                    ss += (h0.x * h0.x + h0.y * h0.y) + (h0.z * h0.z + h0.w * h0.w) + (h1.x * h1.x + h1.y * h1.y) + (h1.z * h1.z + h1.w * h1.w);
                    *(f32x4*)(out + idx) = h0; *(f32x4*)(out + idx + 4) = h1;
                }
                ss += __shfl_xor(ss, 16); ss += __shfl_xor(ss, 32);
                if (fq == 0) atomicAdd(rss + row, ss);
            }
    }
};

constexpr int AK_LD = 136, AV_LD = 72;
constexpr int ATT_BUF = (64 * AK_LD + 128 * AV_LD) * 2;
__device__ __forceinline__ void attn_unit(const Params& p, LAS unsigned char* lds, int unit, int tid) {
    const int hp = unit & 1, kvh = (unit >> 1) & 3, qb = (unit >> 3) & 31, b = unit >> 8;
    const int wave = tid >> 6, lane = tid & 63, r = lane & 31, h = lane >> 5;
    const int head = kvh * 4 + hp * 2 + (wave >> 2);
    const int tq = qb * 128 + (wave & 3) * 32 + r;
    u16* Q = (u16*)(p.ws + WS_Q);
    const u16* Kb = (const u16*)(p.ws + WS_K); const u16* VTb = (const u16*)(p.ws + WS_VT);
    const u16* KC = (const u16*)(p.ws + WS_KC); const u16* VCT = (const u16*)(p.ws + WS_VCT);
    bf16x8 qf[8];
    { const u16* qp = Q + ((size_t)(b * T + tq)) * D + head * 128 + 8 * h;
#pragma unroll
      for (int s = 0; s < 8; ++s) qf[s] = *(const bf16x8*)(qp + 16 * s); }
    float m_run = p.sink[head] * LOG2E; float l_run = (h == 0) ? 1.f : 0.f;
    f32x16 o[4];
#pragma unroll
    for (int mt = 0; mt < 4; ++mt)
#pragma unroll
        for (int i = 0; i < 16; ++i) o[mt][i] = 0.f;
    const int jb = (qb == 0) ? 2 : 0, je = (qb == 31) ? 4 : 6, nw = je - jb, ntile = nw + 4;
    u32x4 kreg[2], vreg[2];
#define ATT_LOAD(i) do { const int _i = (i); const u16* ks; const u16* vs; size_t vld; \
        if (_i < nw) { const int key0 = qb * 128 - 128 + 64 * (jb + _i); ks = Kb + ((size_t)(b * T + key0)) * 512 + kvh * 128; vs = VTb + ((size_t)((b * 4 + kvh) * 128)) * T + key0; vld = T; } \
        else { const int key0 = 64 * (_i - nw); ks = KC + ((size_t)(b * LC + key0)) * 512 + kvh * 128; vs = VCT + ((size_t)((b * 4 + kvh) * 128)) * LC + key0; vld = LC; } \
        _Pragma("unroll") for (int _j = 0; _j < 2; ++_j) { const int ch = tid + 512 * _j; \
            kreg[_j] = *(const u32x4*)(ks + (size_t)(ch >> 4) * 512 + (ch & 15) * 8); \
            vreg[_j] = *(const u32x4*)(vs + (size_t)(ch >> 3) * vld + (ch & 7) * 8); } } while (0)
#define ATT_STORE(bufi) do { LAS u16* kt = (LAS u16*)(lds + (bufi) * ATT_BUF); LAS u16* vt = kt + 64 * AK_LD; \
        _Pragma("unroll") for (int _j = 0; _j < 2; ++_j) { const int ch = tid + 512 * _j; \
            *(LAS u32x4*)(kt + (ch >> 4) * AK_LD + (ch & 15) * 8) = kreg[_j]; \
            LAS u16* vrow = vt + (ch >> 3) * AV_LD + ((ch & 7) >> 1) * 16 + ((ch & 1) ? 4 : 0);     \
            *(LAS u32x2*)vrow = (u32x2){vreg[_j].x, vreg[_j].y}; *(LAS u32x2*)(vrow + 8) = (u32x2){vreg[_j].z, vreg[_j].w}; } } while (0)
    ATT_LOAD(0); ATT_STORE(0);
    __syncthreads();
    for (int it = 0; it < ntile; ++it) {
        if (it + 1 < ntile) ATT_LOAD(it + 1);
        const LAS u16* kt = (const LAS u16*)(lds + (it & 1) * ATT_BUF); const LAS u16* vt = kt + 64 * AK_LD;
        int cls = 2; int key0 = 0;
        if (it < nw) { key0 = qb * 128 - 128 + 64 * (jb + it); const int q0 = qb * 128 + (wave & 3) * 32;
            if (key0 + 63 < q0 - 128 || key0 > q0 + 31 + 128) cls = 0;
            else if (key0 < q0 + 31 - 128 || key0 + 63 > q0 + 128) cls = 1; }
        if (cls != 0) {
        f32x16 sa[2];
        __builtin_amdgcn_s_setprio(1);
#pragma unroll
        for (int k2 = 0; k2 < 2; ++k2) {
#pragma unroll
            for (int i = 0; i < 16; ++i) sa[k2][i] = 0.f;
#pragma unroll
            for (int s = 0; s < 8; ++s) { const bf16x8 kf = *(const LAS bf16x8*)(kt + (32 * k2 + r) * AK_LD + 16 * s + 8 * h); sa[k2] = MFMA32(kf, qf[s], sa[k2]); }
        }
        __builtin_amdgcn_s_setprio(0);
        if (cls == 1) {
#pragma unroll
            for (int k2 = 0; k2 < 2; ++k2)
#pragma unroll
                for (int i = 0; i < 16; ++i) { const int dk = tq - (key0 + 32 * k2 + crow(i, h)); if (dk > 128 || dk < -128) sa[k2][i] = -INFINITY; }
        }
        float tmax = sa[0][0];
#pragma unroll
        for (int k2 = 0; k2 < 2; ++k2)
#pragma unroll
            for (int i = 0; i < 16; ++i) tmax = fmaxf(tmax, sa[k2][i]);
        tmax = fmaxf(tmax, __shfl_xor(tmax, 32));
        if (__builtin_amdgcn_ballot_w64(tmax > m_run + 8.f) != 0ull) {
            const float m_new = fmaxf(m_run, tmax); const float alpha = fexp2(m_run - m_new); m_run = m_new;
            l_run *= alpha;
#pragma unroll
            for (int mt = 0; mt < 4; ++mt)
#pragma unroll
                for (int i = 0; i < 16; ++i) o[mt][i] *= alpha;
        }
        float lsum = 0.f;
#pragma unroll
        for (int k2 = 0; k2 < 2; ++k2)
#pragma unroll
            for (int i = 0; i < 16; ++i) { const float pe = fexp2(sa[k2][i] - m_run); sa[k2][i] = pe; lsum += pe; }
        l_run += lsum;
        __builtin_amdgcn_s_setprio(1);
#pragma unroll
        for (int k2 = 0; k2 < 2; ++k2)
#pragma unroll
            for (int s2 = 0; s2 < 2; ++s2) {
                u32x4 pk; pk.x = pk2(sa[k2][8 * s2 + 0], sa[k2][8 * s2 + 1]); pk.y = pk2(sa[k2][8 * s2 + 2], sa[k2][8 * s2 + 3]);
                pk.z = pk2(sa[k2][8 * s2 + 4], sa[k2][8 * s2 + 5]); pk.w = pk2(sa[k2][8 * s2 + 6], sa[k2][8 * s2 + 7]);
                const bf16x8 pf = __builtin_bit_cast(bf16x8, pk);
#pragma unroll
                for (int mt = 0; mt < 4; ++mt) {
                    const u32x4 vv = *(const LAS u32x4*)(vt + (32 * mt + r) * AV_LD + 32 * k2 + 16 * s2 + 8 * h);
                    o[mt] = MFMA32(__builtin_bit_cast(bf16x8, vv), pf, o[mt]);
                }
            }
        __builtin_amdgcn_s_setprio(0);
        }
        if (it + 1 < ntile) ATT_STORE((it + 1) & 1);
        __syncthreads();
    }
    const float ltot = l_run + __shfl_xor(l_run, 32); const float inv = 1.f / ltot;
    u16* op = Q + ((size_t)(b * T + tq)) * D + head * 128;
#pragma unroll
    for (int mt = 0; mt < 4; ++mt)
#pragma unroll
        for (int q4 = 0; q4 < 4; ++q4) {
            u32x2 w; w.x = pk2(o[mt][4 * q4 + 0] * inv, o[mt][4 * q4 + 1] * inv); w.y = pk2(o[mt][4 * q4 + 2] * inv, o[mt][4 * q4 + 3] * inv);
            *(u32x2*)(op + 32 * mt + 8 * q4 + 4 * h) = w;
        }
#undef ATT_LOAD
#undef ATT_STORE
}

constexpr int HG_QH_LD = 136, HG_LD = 40;
constexpr int HG_OFF_QH = 0, HG_OFF_KHT = 32 * HG_QH_LD * 2, HG_OFF_VT = HG_OFF_KHT + 128 * HG_LD * 2, HG_OFF_AP = HG_OFF_VT + 128 * HG_LD * 2, HG_OFF_DEC = HG_OFF_AP + 4 * 32 * HG_LD * 2;
constexpr int HG_BUF = HG_OFF_DEC + 512;
constexpr int HG_PRIV = 2 * HG_BUF;
constexpr int NSTEP = 8 + 128;
constexpr int HG_RAW = HG_PRIV + 4 * 2 * 32 * HG_LD * 2, HG_RAW_A = 33 * 64, HG_RAW_W = 3 * HG_RAW_A;
static_assert(HG_RAW + 4 * HG_RAW_W <= LDS_BYTES, "hgrn lds");

__device__ __forceinline__ void hgrn_unit(const Params& p, LAS unsigned char* lds, int unit, int tid) {
    const int dir = unit & 1, hh = (unit >> 1) & 15, b = unit >> 5;
    const int wave = tid >> 6, lane = tid & 63, r = lane & 31, h = lane >> 5;
    const u16* LF = (const u16*)(p.ws + (dir ? WS_LFB : WS_LFF)); const u16* CLF = (const u16*)(p.ws + (dir ? WS_CFB : WS_CFF));
    const u16* QHg = (const u16*)(p.ws + WS_QH); const u16* VHg = (const u16*)(p.ws + WS_VH); const u16* CIg = (const u16*)(p.ws + WS_CI);
    u16* OUTg = (u16*)(p.ws + (dir ? WS_LFB : WS_LFF));
    if (wave >= 4) {
        const int pw = wave - 4;
        LAS u16* QTp = (LAS u16*)(lds + HG_PRIV + pw * (2 * 32 * HG_LD * 2)); LAS u16* KHp = QTp + 32 * HG_LD;
        LAS unsigned char* RAW = lds + HG_RAW + pw * HG_RAW_W;
        const int li = lane >> 2, lc4 = lane & 3;
        const int gcol = hh * 128 + 32 * pw + 8 * lc4;
        u32x4 R0[6], R1[6];
#define HG_LOAD(RS, s) do { const int _s = ((s) < NSTEP) ? (s) : (NSTEP - 1); const bool _ctx = _s < 8; const int _cc = _ctx ? _s : _s - 8; const int _TL = _ctx ? LC : T; \
        const u16* _lf = _ctx ? CLF : LF; const u16* _vs = _ctx ? CIg : VHg; const u16* _qs = _ctx ? CIg : QHg; const unsigned _qm = _ctx ? 0u : 0xffffffffu; \
        _Pragma("unroll") for (int jj = 0; jj < 2; ++jj) { const int pos = 32 * _cc + li + 16 * jj; const int t = dir ? (_TL - 1 - pos) : pos; const size_t idx = ((size_t)(b * _TL + t)) * D + gcol; \
            RS[jj] = *(const u32x4*)(_lf + idx); RS[2 + jj] = *(const u32x4*)(_vs + idx); const u32x4 _q = *(const u32x4*)(_qs + idx); RS[4 + jj] = (u32x4){_q.x & _qm, _q.y & _qm, _q.z & _qm, _q.w & _qm}; } } while (0)
#define HG_BUILD(RS, s) do { const int _sb = (s); \
        LAS unsigned char* buf = lds + (_sb & 1) * HG_BUF; \
        _Pragma("unroll") for (int jj = 0; jj < 2; ++jj) { const int ro = (li + 16 * jj) * 64 + jj * 64 + lc4 * 16; \
            *(LAS u32x4*)(RAW + ro) = RS[jj]; *(LAS u32x4*)(RAW + HG_RAW_A + ro) = RS[2 + jj]; *(LAS u32x4*)(RAW + 2 * HG_RAW_A + ro) = RS[4 + jj]; } \
        LDS_WAIT(); \
        HG_LOAD(RS, _sb + 2); \
        float kkv[16], P[16]; u16 qv[16], vv[16]; float run = 1.f; \
        _Pragma("unroll") for (int ii = 0; ii < 16; ++ii) { const int ro = (16 * h + ii) * 64 + h * 64 + 2 * r; \
            kkv[ii] = h2f(*(const LAS u16*)(RAW + ro)); vv[ii] = *(const LAS u16*)(RAW + HG_RAW_A + ro); qv[ii] = *(const LAS u16*)(RAW + 2 * HG_RAW_A + ro); } \
        _Pragma("unroll") for (int ii = 0; ii < 16; ++ii) { run *= (1.f - kkv[ii]); P[ii] = run; } \
        const float oth = __shfl_xor(run, 32); const float Et = run * oth; const float invE = __builtin_amdgcn_rcpf(Et); \
        const float preoff = h ? oth : 1.f; const float sufoff = h ? 1.f : oth; \
        unsigned khp[8], vpk[8]; float suf = sufoff; \
        _Pragma("unroll") for (int ii = 15; ii >= 0; --ii) { \
            const float q = bf2f(qv[ii]); const float qhv = q * (P[ii] * preoff); const float khv = kkv[ii] * suf; const float qtv = qhv * invE; \
            suf *= (1.f - kkv[ii]); \
            const int i = 16 * h + ii; \
            ((LAS u16*)(buf + HG_OFF_QH))[i * HG_QH_LD + 32 * pw + r] = (u16)(pk2(qhv, 0.f) & 0xffffu); \
            QTp[i * HG_LD + r] = (u16)(pk2(qtv, 0.f) & 0xffffu); \
            const unsigned kb = pk2(khv, 0.f) & 0xffffu; \
            KHp[i * HG_LD + r] = (u16)kb; \
            if (ii & 1) { khp[ii >> 1] = kb << 16; vpk[ii >> 1] = ((unsigned)vv[ii]) << 16; } else { khp[ii >> 1] |= kb; vpk[ii >> 1] |= (unsigned)vv[ii]; } } \
        { LAS u32x4* kd = (LAS u32x4*)((LAS u16*)(buf + HG_OFF_KHT) + (32 * pw + r) * HG_LD + 16 * h); \
          kd[0] = (u32x4){khp[0], khp[1], khp[2], khp[3]}; kd[1] = (u32x4){khp[4], khp[5], khp[6], khp[7]}; \
          LAS u32x4* vd = (LAS u32x4*)((LAS u16*)(buf + HG_OFF_VT) + (32 * pw + r) * HG_LD + 16 * h); \
          vd[0] = (u32x4){vpk[0], vpk[1], vpk[2], vpk[3]}; vd[1] = (u32x4){vpk[4], vpk[5], vpk[6], vpk[7]}; \
          if (h == 0) ((LAS float*)(buf + HG_OFF_DEC))[32 * pw + r] = Et; } \
        LDS_WAIT(); \
        f32x16 a; \
        _Pragma("unroll") for (int i = 0; i < 16; ++i) a[i] = 0.f; \
        _Pragma("unroll") for (int s2 = 0; s2 < 2; ++s2) { const bf16x8 af = *(const LAS bf16x8*)(KHp + r * HG_LD + 16 * s2 + 8 * h); const bf16x8 bfg = *(const LAS bf16x8*)(QTp + r * HG_LD + 16 * s2 + 8 * h); a = MFMA32(af, bfg, a); } \
        LAS u16* ap = (LAS u16*)(buf + HG_OFF_AP) + (pw * 32 + r) * HG_LD; \
        _Pragma("unroll") for (int q4 = 0; q4 < 4; ++q4) { float w[4]; \
            _Pragma("unroll") for (int e = 0; e < 4; ++e) { const int j = 8 * q4 + 4 * h + e; w[e] = (j <= r) ? a[4 * q4 + e] : 0.f; } \
            *(LAS u32x2*)(ap + 8 * q4 + 4 * h) = (u32x2){pk2(w[0], w[1]), pk2(w[2], w[3])}; } } while (0)
        HG_LOAD(R0, 0); HG_LOAD(R1, 1);
        for (int s = 0; s < NSTEP; s += 2) {
            HG_BUILD(R0, s);
            BAR_LDS();
            HG_BUILD(R1, s + 1);
            BAR_LDS();
        }
        BAR_LDS();
#undef HG_LOAD
#undef HG_BUILD
    } else {
        const int n = wave;
        f32x16 S[4];
#pragma unroll
        for (int kt = 0; kt < 4; ++kt)
#pragma unroll
            for (int i = 0; i < 16; ++i) S[kt][i] = 0.f;
        for (int s = 0; s <= NSTEP; ++s) {
            if (s >= 1) {
                const int cs = s - 1;
                const LAS unsigned char* buf = lds + (cs & 1) * HG_BUF;
                const LAS u16* QHs = (const LAS u16*)(buf + HG_OFF_QH); const LAS u16* KHT = (const LAS u16*)(buf + HG_OFF_KHT);
                const LAS u16* VTs = (const LAS u16*)(buf + HG_OFF_VT); const LAS u16* AP = (const LAS u16*)(buf + HG_OFF_AP); const LAS float* DEC = (const LAS float*)(buf + HG_OFF_DEC);
                bf16x8 vf[2], ka[4][2];
#pragma unroll
                for (int s2 = 0; s2 < 2; ++s2) vf[s2] = *(const LAS bf16x8*)(VTs + (32 * n + r) * HG_LD + 16 * s2 + 8 * h);
                if (cs >= 8) {
                    bf16x8 qa[4][2], apf[4][2], sp[4][2];
#pragma unroll
                    for (int kt = 0; kt < 4; ++kt)
#pragma unroll
                        for (int s2 = 0; s2 < 2; ++s2) {
                            const LAS u16* qp = QHs + r * HG_QH_LD + 32 * kt + 16 * s2 + 4 * h;
                            const u32x2 lo = *(const LAS u32x2*)qp, hi = *(const LAS u32x2*)(qp + 8);
                            const u32x4 q4v = {lo.x, lo.y, hi.x, hi.y};
                            qa[kt][s2] = __builtin_bit_cast(bf16x8, q4v);
                            apf[kt][s2] = *(const LAS bf16x8*)(AP + (kt * 32 + r) * HG_LD + 16 * s2 + 8 * h);
                        }
#pragma unroll
                    for (int kt = 0; kt < 4; ++kt)
#pragma unroll
                        for (int s2 = 0; s2 < 2; ++s2) {
                            u32x4 spk; spk.x = pk2(S[kt][8 * s2 + 0], S[kt][8 * s2 + 1]); spk.y = pk2(S[kt][8 * s2 + 2], S[kt][8 * s2 + 3]);
                            spk.z = pk2(S[kt][8 * s2 + 4], S[kt][8 * s2 + 5]); spk.w = pk2(S[kt][8 * s2 + 6], S[kt][8 * s2 + 7]);
                            sp[kt][s2] = __builtin_bit_cast(bf16x8, spk);
                        }
                    f32x16 o1, o2;
#pragma unroll
                    for (int i = 0; i < 16; ++i) { o1[i] = 0.f; o2[i] = 0.f; }
#pragma unroll
                    for (int kt = 0; kt < 4; ++kt)
#pragma unroll
                        for (int s2 = 0; s2 < 2; ++s2) { o1 = MFMA32(qa[kt][s2], sp[kt][s2], o1); o2 = MFMA32(apf[kt][s2], vf[s2], o2); }
#pragma unroll
                    for (int kt = 0; kt < 4; ++kt)
#pragma unroll
                        for (int s2 = 0; s2 < 2; ++s2) ka[kt][s2] = *(const LAS bf16x8*)(KHT + (32 * kt + r) * HG_LD + 16 * s2 + 8 * h);
#pragma unroll
                    for (int kt = 0; kt < 4; ++kt) {
#pragma unroll
                        for (int q4 = 0; q4 < 4; ++q4) { const f32x4 d4 = *(const LAS f32x4*)(DEC + 32 * kt + 8 * q4 + 4 * h);
                            S[kt][4 * q4 + 0] *= d4.x; S[kt][4 * q4 + 1] *= d4.y; S[kt][4 * q4 + 2] *= d4.z; S[kt][4 * q4 + 3] *= d4.w; }
#pragma unroll
                        for (int s2 = 0; s2 < 2; ++s2) S[kt] = MFMA32(ka[kt][s2], vf[s2], S[kt]);
                    }
                    const int cc = cs - 8;
                    if (dir) {
                        u16* ob = OUTg + ((size_t)(b * T + (T - 1 - 32 * cc - 4 * h))) * D + hh * 128 + 32 * n + r;
#pragma unroll
                        for (int i = 0; i < 16; ++i) ob[-(ptrdiff_t)(((i & 3) + 8 * (i >> 2)) * D)] = (u16)(pkh2(o1[i] + o2[i], 0.f) & 0xffffu);
                    } else {
                        u16* of = OUTg + ((size_t)(b * T + 32 * cc + 4 * h)) * D + hh * 128 + 32 * n + r;
#pragma unroll
                        for (int i = 0; i < 16; ++i) of[(size_t)(((i & 3) + 8 * (i >> 2)) * D)] = (u16)(pkh2(o1[i] + o2[i], 0.f) & 0xffffu);
                    }
                } else {
#pragma unroll
                    for (int kt = 0; kt < 4; ++kt)
#pragma unroll
                        for (int s2 = 0; s2 < 2; ++s2) ka[kt][s2] = *(const LAS bf16x8*)(KHT + (32 * kt + r) * HG_LD + 16 * s2 + 8 * h);
#pragma unroll
                    for (int kt = 0; kt < 4; ++kt) {
#pragma unroll
                        for (int q4 = 0; q4 < 4; ++q4) { const f32x4 d4 = *(const LAS f32x4*)(DEC + 32 * kt + 8 * q4 + 4 * h);
                            S[kt][4 * q4 + 0] *= d4.x; S[kt][4 * q4 + 1] *= d4.y; S[kt][4 * q4 + 2] *= d4.z; S[kt][4 * q4 + 3] *= d4.w; }
#pragma unroll
                        for (int s2 = 0; s2 < 2; ++s2) S[kt] = MFMA32(ka[kt][s2], vf[s2], S[kt]);
                    }
                }
            }
            BAR_LDS();
        }
    }
}

__device__ __forceinline__ void phase3b(const Params& p, int gw, int NGW, int lane) {
    const u16* OFh = (const u16*)(p.ws + WS_LFF); const u16* OBh = (const u16*)(p.ws + WS_LFB); u16* OB = (u16*)(p.ws + WS_OB);
    for (int row = gw; row < M; row += NGW) {
#pragma unroll
        for (int j = 0; j < 4; ++j) {
            const int c = 512 * j + 8 * lane; const size_t idx = (size_t)row * D + c;
            const u32x4 aa = *(const u32x4*)(OFh + idx); const u32x4 bb = *(const u32x4*)(OBh + idx);
            float v[8];
#pragma unroll
            for (int e = 0; e < 4; ++e) { const unsigned ua = aa[e], ub = bb[e];
                v[2 * e] = h2f((u16)(ua & 0xffffu)) + h2f((u16)(ub & 0xffffu)); v[2 * e + 1] = h2f((u16)(ua >> 16)) + h2f((u16)(ub >> 16)); }
            float ss = 0.f;
#pragma unroll
            for (int e = 0; e < 8; ++e) ss += v[e] * v[e];
            ss += __shfl_xor(ss, 1); ss += __shfl_xor(ss, 2); ss += __shfl_xor(ss, 4); ss += __shfl_xor(ss, 8);
            const float rstd = __builtin_amdgcn_rsqf(ss * (1.f / 128.f) + EPS);
            const f32x4 g0 = *(const f32x4*)(p.hg_gain + c), g1 = *(const f32x4*)(p.hg_gain + c + 4);
            v[0] *= rstd * g0.x; v[1] *= rstd * g0.y; v[2] *= rstd * g0.z; v[3] *= rstd * g0.w; v[4] *= rstd * g1.x; v[5] *= rstd * g1.y; v[6] *= rstd * g1.z; v[7] *= rstd * g1.w;
            *(u32x4*)(OB + idx) = pack8(v);
        }
    }
}

__device__ __forceinline__ void phase7(const Params& p, int gw, int NGW, int lane) {
    const float* rss = (const float*)(p.ws + WS_RSS);
    f32x4 g[8];
#pragma unroll
    for (int j = 0; j < 8; ++j) g[j] = *((const f32x4*)p.fgain + lane + 64 * j);
    for (int row = gw; row < M; row += 2 * NGW) {
        const int row2 = row + NGW; const bool has2 = row2 < M;
        f32x4* o1 = (f32x4*)(p.out + (size_t)row * D) + lane; f32x4* o2 = (f32x4*)(p.out + (size_t)(has2 ? row2 : row) * D) + lane;
        f32x4 v1[8], v2[8];
#pragma unroll
        for (int j = 0; j < 8; ++j) { v1[j] = o1[64 * j]; v2[j] = o2[64 * j]; }
        const float r1 = __builtin_amdgcn_rsqf(rss[row] * (1.f / D) + EPS), r2 = __builtin_amdgcn_rsqf(rss[has2 ? row2 : row] * (1.f / D) + EPS);
#pragma unroll
        for (int j = 0; j < 8; ++j) o1[64 * j] = v1[j] * r1 * g[j];
        if (has2) {
#pragma unroll
            for (int j = 0; j < 8; ++j) o2[64 * j] = v2[j] * r2 * g[j];
        }
    }
}

#define XB_TMO      128
#define XB_XCNT(j)  (256  + 64 * (j))
#define XB_XSUB(j)  (1280 + 64 * (j))
#define XB_XGEN(j)  (2304 + 64 * (j))
#define XB_TOP      3328
#define XB_TOPGEN   3392
#define XCD_BAR_WORDS 3456
#define XB_SPIN_CAP (1u << 18)
__device__ __forceinline__ unsigned xb_ld(unsigned* p)              { return __hip_atomic_load(p, __ATOMIC_RELAXED, __HIP_MEMORY_SCOPE_AGENT); }
__device__ __forceinline__ unsigned xb_add(unsigned* p, unsigned v) { return __hip_atomic_fetch_add(p, v, __ATOMIC_RELAXED, __HIP_MEMORY_SCOPE_AGENT); }
__device__ __forceinline__ unsigned xb_xcc_id() { return (unsigned)__builtin_amdgcn_s_getreg((3 << 11) | 20) & 0xFu; }
#define XB_SPIN(cond, bar) do { unsigned _sp = 0; while (cond) { __builtin_amdgcn_s_sleep(1); \
    if ((++_sp & 255u) == 0u) { if (xb_ld(&(bar)[XB_TMO])) break; if (_sp > XB_SPIN_CAP) { atomicAdd(&(bar)[XB_TMO], 1u); break; } } } } while (0)
struct XcdBarrier { unsigned* bar; unsigned x; volatile LAS unsigned* st; };
__device__ __forceinline__ XcdBarrier xcd_barrier_post(unsigned* bar, volatile LAS unsigned* st) {
    XcdBarrier b; b.bar = bar; b.x = xb_xcc_id(); b.st = st;
    if (threadIdx.x == 0) (void)xb_add(&bar[XB_XCNT(b.x)], 1u);
    return b;
}
__device__ __forceinline__ void xcd_barrier_complete(unsigned* bar, unsigned x, unsigned& nloc, unsigned& nx) {
    const unsigned G = gridDim.x * gridDim.y * gridDim.z;
    unsigned sum, cnt, mine, sp = 0u;
    for (;;) {
        sum = 0u; cnt = 0u; mine = 0u;
#pragma unroll
        for (unsigned j = 0; j < 16; ++j) { const unsigned c = xb_ld(&bar[XB_XCNT(j)]); sum += c; cnt += (c > 0u) ? 1u : 0u; mine = (j == x) ? c : mine; }
        if (sum == G) break;
        __builtin_amdgcn_s_sleep(1);
        if ((++sp & 255u) == 0u) { if (xb_ld(&bar[XB_TMO])) break; if (sp > XB_SPIN_CAP) { atomicAdd(&bar[XB_TMO], 1u); break; } }
    }
    nloc = mine > 0u ? mine : 1u; nx = cnt > 0u ? cnt : 1u;
}
__device__ __forceinline__ void xcd_barrier(const XcdBarrier& b) {
    asm volatile("s_waitcnt vmcnt(0)" ::: "memory");
    __syncthreads();
    if (threadIdx.x == 0) {
        unsigned* bar = b.bar;
        __builtin_amdgcn_s_waitcnt(0);
        unsigned nloc = b.st[0], nx = b.st[1];
        if (nloc == 0u) { xcd_barrier_complete(bar, b.x, nloc, nx); b.st[0] = nloc; b.st[1] = nx; }
        const unsigned old = xb_add(&bar[XB_XSUB(b.x)], 1u);
        const unsigned gen = old / nloc;
        if (old + 1u == (gen + 1u) * nloc) {
            __builtin_amdgcn_fence(__ATOMIC_RELEASE, "agent");
            asm volatile("s_waitcnt vmcnt(0)" ::: "memory");
            const unsigned og = xb_add(&bar[XB_TOP], 1u);
            const unsigned tg = og / nx;
            if (og + 1u == (tg + 1u) * nx) xb_add(&bar[XB_TOPGEN], 1u);
            else XB_SPIN(xb_ld(&bar[XB_TOPGEN]) == tg, bar);
            __builtin_amdgcn_fence(__ATOMIC_ACQUIRE, "agent");
            xb_add(&bar[XB_XGEN(b.x)], 1u);
            asm volatile("s_waitcnt vmcnt(0)" ::: "memory");
        } else {
            XB_SPIN(xb_ld(&bar[XB_XGEN(b.x)]) == gen, bar);
            __builtin_amdgcn_fence(__ATOMIC_ACQUIRE, "agent");
            asm volatile("s_waitcnt vmcnt(0)" ::: "memory");
        }
    }
    __syncthreads();
}

__global__ void __launch_bounds__(NTHREADS, 2) mega(Params p) {
    extern __shared__ __attribute__((aligned(16))) unsigned char lds_raw[];
    LAS unsigned char* lds = (LAS unsigned char*)lds_raw;
    cg::grid_group grid = cg::this_grid();
    const int tid = threadIdx.x, lane = tid & 63, wave = __builtin_amdgcn_readfirstlane(tid >> 6);
    const int G = gridDim.x, bid = blockIdx.x;
    const int gw = bid * 8 + wave, NGW = G * 8;
    const int lo = p.ph_lo, hi = p.ph_hi;
#define IN(k) (lo <= (k) && (k) < hi)
#define SEAM(k) do { if (IN(k) && IN((k) + 1)) xcd_barrier(xbar); } while (0)
    for (int i = tid; i < (LDS_BYTES - LDS_CTL) / 4; i += NTHREADS) ((LAS unsigned*)(lds + LDS_CTL))[i] = 0u;
    __syncthreads();
    const XcdBarrier xbar = xcd_barrier_post((unsigned*)(p.ws + WS_BAR), (volatile LAS unsigned*)(lds + LDS_CTL + 64));
    if (lo < 0) grid.sync();
    phase0_mod(p, gw, NGW, lane);
    SEAM(0);
    phase0_tr(p, lds, gw, NGW, wave, lane);
    phase1(p, gw, NGW, lane);
    SEAM(1);
    if (IN(2)) {
        pg8::Gemm g{(const u16*)(p.ws + WS_XN), (const u16*)(p.ws + WS_WINT), MTOT, N1, D};
        pg8::Order1 S{G, bid};
        EpiIn E{p.ws, p.lb_f, p.lb_b, p.b_merge, (u16*)p.out};
        pg8::gemm_phase<EpiIn, pg8::Order1>(lds, g, S, E);
    }
    SEAM(2);
    if (IN(3)) {
        if (bid < 128) { for (int u = bid; u < 128; u += (G < 128 ? G : 128)) hgrn_unit(p, lds, u, tid); }
        unsigned* qctr = (unsigned*)(p.ws + WS_QCTR);
        LAS int* sh = (LAS int*)(lds + LDS_CTL);
        int nxtq = 0;
        if (tid == 0) nxtq = (int)atomicAdd(qctr, 1u);
        for (;;) {
            if (tid == 0) sh[0] = nxtq;
            __syncthreads();
            const int pr = sh[0];
            __syncthreads();
            if (pr >= 880 + 1024) break;
            if (tid == 0) nxtq = (int)atomicAdd(qctr, 1u);
            if (pr >= 880) attn_unit(p, lds, pr - 880, tid);
            else {
                pg8::Gemm g{(const u16*)(p.ws + WS_XN), (const u16*)(p.ws + WS_WINT), MTOT, NCOL, D};
                pg8::OrderSingle S{144 + pr};
                EpiIn E{p.ws, p.lb_f, p.lb_b, p.b_merge, (u16*)p.out};
                pg8::gemm_phase<EpiIn, pg8::OrderSingle>(lds, g, S, E);
            }
        }
    }
    SEAM(3);
    if (IN(5)) {
        pg8::Gemm g{(const u16*)(p.ws + WS_XN), (const u16*)(p.ws + WS_WINT) + (size_t)N1 * D, M, 4096, D};
        pg8::StaticOrder S; S.init(M, 4096, G, bid);
        EpiGate E{p.ws, p.hg_gain, lds};
        pg8::gemm_phase<EpiGate, pg8::StaticOrder>(lds, g, S, E);
    }
    SEAM(5);
    if (IN(6)) {
        pg8::StaticOrder S; S.init(M, D, G, bid);
        { pg8::Gemm g{(const u16*)(p.ws + WS_OB), (const u16*)(p.ws + WS_WH), M, D, D}; EpiMerge<0> E{p.ws, (float*)(p.ws + WS_LFF), (const u16*)p.out}; pg8::gemm_phase<EpiMerge<0>, pg8::StaticOrder>(lds, g, S, E); }
        { pg8::Gemm g{(const u16*)(p.ws + WS_Q), (const u16*)(p.ws + WS_WA), M, D, D}; EpiMerge<1> E{p.ws, (float*)(p.ws + WS_LFF), (const u16*)p.out}; pg8::gemm_phase<EpiMerge<1>, pg8::StaticOrder>(lds, g, S, E); }
    }
    SEAM(6);
    if (IN(7)) {
        pg8::StaticOrder S; S.init(M, D, G, bid);
        pg8::Gemm g{(const u16*)(p.ws + WS_QH), (const u16*)(p.ws + WS_WO), M, D, D};
        EpiOut E{p.x, (const float*)(p.ws + WS_MOD), p.b_ada, p.out, (float*)(p.ws + WS_RSS)};
        pg8::gemm_phase<EpiOut, pg8::StaticOrder>(lds, g, S, E);
    }
    SEAM(7);
    if (IN(8)) phase7(p, gw, NGW, lane);
}

#ifndef N_LAUNCH_SPLIT
#define N_LAUNCH_SPLIT 0
#endif
extern "C" void kernel_launch(void* const* d_in, const int* in_sizes, int n_in, void* d_out, int out_size, void* d_ws, size_t ws_size, hipStream_t stream) {
    static int grid = 0;
    if (!grid) {
        int dev = 0, cus = 0, per_cu = 0;
        hipGetDevice(&dev);
        hipDeviceGetAttribute(&cus, hipDeviceAttributeMultiprocessorCount, dev);
        hipFuncSetAttribute((const void*)mega, hipFuncAttributeMaxDynamicSharedMemorySize, LDS_BYTES);
        hipOccupancyMaxActiveBlocksPerMultiprocessor(&per_cu, (const void*)mega, NTHREADS, LDS_BYTES);
        if (per_cu < 1) per_cu = 1;
        grid = cus * 1;
        if (ws_size < WS_END) { fprintf(stderr, "workspace too small: %zu < %zu\n", ws_size, (size_t)WS_END); grid = -1; }
    }
    if (grid <= 0) return;
    Params p{};
    p.x = (const float*)d_in[0]; p.c = (const float*)d_in[1]; p.ctx = (const float*)d_in[2]; p.c_ctx = (const float*)d_in[3];
    p.w_ada = (const float*)d_in[4]; p.b_ada = (const float*)d_in[5]; p.norm_gain = (const float*)d_in[6]; p.w_in = (const float*)d_in[7];
    p.b_merge = (const float*)d_in[8]; p.lb_f = (const float*)d_in[9]; p.lb_b = (const float*)d_in[10]; p.hg_gain = (const float*)d_in[11];
    p.w_o_hgrn = (const float*)d_in[12]; p.sink = (const float*)d_in[13]; p.w_o_attn = (const float*)d_in[14]; p.w_out = (const float*)d_in[15];
    p.fgain = (const float*)d_in[16];
    p.out = (float*)d_out; p.ws = (unsigned char*)d_ws;
    hipMemsetAsync(d_ws, 0, CTL_ZERO, stream);
#if N_LAUNCH_SPLIT
    for (int ph = 0; ph < 9; ++ph) { p.ph_lo = ph; p.ph_hi = ph + 1; hipLaunchKernelGGL(mega, dim3(grid), dim3(NTHREADS), LDS_BYTES, stream, p); }
#else
    p.ph_lo = 0; p.ph_hi = 9;
    void* args[] = {&p};
    hipError_t e = hipLaunchCooperativeKernel((const void*)mega, dim3(grid), dim3(NTHREADS), args, LDS_BYTES, stream);
    if (e != hipSuccess) fprintf(stderr, "cooperative launch failed: %s (grid %d)\n", hipGetErrorString(e), grid);
#endif
}
```

```cpp
#include <hip/hip_runtime.h>
#include <hip/hip_cooperative_groups.h>
#include <cstdio>
#include <cstdint>
namespace cg = cooperative_groups;

#define LAS __attribute__((address_space(3)))
typedef unsigned short u16;
typedef short bf16x8 __attribute__((ext_vector_type(8)));
typedef short s16x4 __attribute__((ext_vector_type(4)));
typedef float f32x2 __attribute__((ext_vector_type(2)));
typedef float f32x4 __attribute__((ext_vector_type(4)));
typedef float f32x16 __attribute__((ext_vector_type(16)));
typedef unsigned u32x2 __attribute__((ext_vector_type(2)));
typedef unsigned u32x4 __attribute__((ext_vector_type(4)));
typedef __bf16 bf2_t __attribute__((ext_vector_type(2)));
typedef _Float16 h2_t __attribute__((ext_vector_type(2)));

constexpr int D = 2048, NB = 4, T = 4096, M = NB * T, LC = 256, MC = NB * LC, MTOT = M + MC;
constexpr int NCOL = 19456, N1 = 11264, N2 = 8192;
constexpr int NMOD = 3 * D;
constexpr float EPS = 1e-6f;
constexpr float LOG2E = 1.4426950408889634f;
constexpr int NTHREADS = 512;
constexpr int LDS_BYTES = 131072 + 4096;
constexpr int LDS_SSB = 131072 + 1024;
constexpr int LDS_CTL = 131072;

constexpr size_t MiB = 1u << 20;
constexpr size_t WS_MOD = 0;
constexpr size_t WS_RSS = 131072;
constexpr size_t WS_QCTR = 200704;
constexpr size_t WS_BAR = 204800;
constexpr size_t CTL_ZERO = 262144;
constexpr size_t WS_WINT = 1 * MiB;
constexpr size_t WS_WH = 77 * MiB, WS_WA = 85 * MiB, WS_WO = 93 * MiB;
constexpr size_t WS_XN = 101 * MiB;
constexpr size_t WS_Q = 169 * MiB;
constexpr size_t WS_K = 233 * MiB;
constexpr size_t WS_VT = 249 * MiB;
constexpr size_t WS_QH = 265 * MiB;
constexpr size_t WS_LFF = 329 * MiB;
constexpr size_t WS_LFB = 393 * MiB;
constexpr size_t WS_VH = 457 * MiB;
constexpr size_t WS_KC = 521 * MiB;
constexpr size_t WS_VCT = 522 * MiB;
constexpr size_t WS_CFF = 523 * MiB, WS_CFB = 527 * MiB, WS_CI = 531 * MiB;
constexpr size_t WS_OB = 535 * MiB;
constexpr size_t WS_END = 599 * MiB;

__device__ __forceinline__ unsigned pk2(float a, float b) { f32x2 v = {a, b}; bf2_t r = __builtin_convertvector(v, bf2_t); return __builtin_bit_cast(unsigned, r); }
__device__ __forceinline__ unsigned pkh2(float a, float b) { f32x2 v = {a, b}; h2_t r = __builtin_convertvector(v, h2_t); return __builtin_bit_cast(unsigned, r); }
__device__ __forceinline__ float bf2f(u16 v) { return __uint_as_float(((unsigned)v) << 16); }
__device__ __forceinline__ float h2f(u16 v) { return (float)__builtin_bit_cast(_Float16, v); }
__device__ __forceinline__ float bflo(unsigned v) { return __uint_as_float(v << 16); }
__device__ __forceinline__ float bfhi(unsigned v) { return __uint_as_float(v & 0xffff0000u); }
__device__ __forceinline__ float fexp2(float x) { return __builtin_amdgcn_exp2f(x); }
__device__ __forceinline__ float sigmoidf_(float x) { return __builtin_amdgcn_rcpf(1.f + fexp2(-x * LOG2E)); }
__device__ __forceinline__ float siluf_(float x) { return x * sigmoidf_(x); }
#define LDS_WAIT() asm volatile("s_waitcnt lgkmcnt(0)" ::: "memory")
#define BAR_LDS() do { asm volatile("s_waitcnt lgkmcnt(0)" ::: "memory"); __builtin_amdgcn_s_barrier(); asm volatile("" ::: "memory"); } while (0)
#define MFMA32(a, b, c) __builtin_amdgcn_mfma_f32_32x32x16_bf16((a), (b), (c), 0, 0, 0)
__device__ __forceinline__ int crow(int reg, int h) { return (reg & 3) + 8 * (reg >> 2) + 4 * h; }

namespace pg8 {
typedef unsigned short bf16_t;
constexpr int BM = 256, BK = 64, HALF = 128, HTB = HALF * BK * 2, STAGE_BYTES = 8 * HTB, NXCD = 8, WGM = 8;
__host__ __device__ __forceinline__ int lds_byte(int r, int c) { const int st = (r >> 4) * 2 + (c >> 5), rr = r & 15, cc = c & 31, ob = rr * 64 + cc * 2; return st * 1024 + (ob ^ (((ob >> 9) & 1) << 5)); }
__host__ __device__ __forceinline__ void stage_rc(int b, int& R, int& C) { const int st = b / 1024, sb = b % 1024, swz = sb ^ (((sb >> 9) & 1) << 5); R = (st >> 1) * 16 + swz / 64; C = (st & 1) * 32 + (swz % 64) / 2; }
__host__ __device__ __forceinline__ int perm32(int rho) { const int n = rho >> 4, i = rho & 15; return 8 * (i >> 2) + 4 * n + (i & 3); }
struct Unit { int pm, pn; };
struct Gemm { const bf16_t* A; const bf16_t* Bt; int M, N, K; };
__device__ __forceinline__ void static_map(int L, int nM, int nN, Unit& u) {
    const int nwg = nM * nN; int wgid = L;
    { const int q = nwg / NXCD, r = nwg % NXCD, xcd = wgid % NXCD, off = wgid / NXCD; wgid = (xcd < r ? xcd * (q + 1) : r * (q + 1) + (xcd - r) * q) + off; }
    const int nig = WGM * nN, gid = wgid / nig, fm = gid * WGM, gsz = (nM - fm) < WGM ? (nM - fm) : WGM;
    u.pm = fm + ((wgid % nig) % gsz); u.pn = (wgid % nig) / gsz;
}
struct StaticOrder {
    int nM, nN, nwg, G, c;
    __device__ void init(int M_, int N_, int G_, int c_) { nM = M_ / BM; nN = N_ / BM; nwg = nM * nN; G = G_; c = c_; }
    __device__ bool next(int i, Unit& u) const { const long L = (long)i * G + c; if (L >= nwg) return false; static_map((int)L, nM, nN, u); return true; }
};
struct Order1 {
    int G, c;
    __device__ bool next(int i, Unit& u) const {
        const long L = (long)i * G + c;
        if (L < 64 * 44) { static_map((int)L, 64, 44, u); return true; }
        if (L < 64 * 44 + 112) { const int idx = (int)L - 64 * 44; u.pm = 64 + (idx & 3); u.pn = idx >> 2; return true; }
        if (L < 64 * 44 + 112 + 144) { static_map((int)L - (64 * 44 + 112), 64, 16, u); u.pn += 60; return true; }
        return false;
    }
};
struct OrderSingle {
    int q;
    __device__ bool next(int i, Unit& u) const { if (i > 0) return false; static_map(q, 64, 16, u); u.pn += 60; return true; }
};

template <class Epi, class Sched, bool ALIGN_EPI = true, bool SP2 = true>
__device__ __forceinline__ void gemm_phase(LAS unsigned char* lds, const Gemm g, const Sched& S, const Epi& E) {
    const int tid = threadIdx.x, wid = __builtin_amdgcn_readfirstlane(tid >> 6), lane = tid & 63, wr = wid >> 2, wc = wid & 3, fr = lane & 15, fq = lane >> 4;
    const int K = g.K, nt = K / BK;
    unsigned voffA[2], voffB[2];
#pragma unroll
    for (int i = 0; i < 2; ++i) { int R, C; stage_rc(tid * 16 + i * 8192, R, C); const int Rb = (R & ~31) + perm32(R & 31);
        voffA[i] = (unsigned)(R * K + C) * 2u; voffB[i] = (unsigned)(Rb * K + C) * 2u; }
    const size_t kstep = (size_t)(BK * 2);
    const int k0r = (int)(((unsigned)__builtin_amdgcn_s_getreg((3 << 11) | 20) & 7u) * (unsigned)(nt >> 3));
#define PG8_KO(t) ((size_t)(((t) + k0r) & (nt - 1)) * kstep)
    const size_t hstep = (size_t)HALF * K * 2;
    const size_t tstep = 2 * hstep;
    const unsigned ldsw = (unsigned)wid * 1024u;
    const int aoff = lds_byte(wr * 64 + fr, fq * 8), boff = lds_byte(wc * 32 + fr, fq * 8);
#define PG8_SA(b, h) (((b) * 2 + (h)) * HTB)
#define PG8_SB(b, h) ((4 + (b) * 2 + (h)) * HTB)
#define PG8_STAGE(bufoff, gbase, voff) do { _Pragma("unroll") for (int _i = 0; _i < 2; ++_i) \
        __builtin_amdgcn_global_load_lds((const unsigned*)((const char*)(gbase) + (voff)[_i]), (LAS unsigned*)(lds + (bufoff) + ldsw + _i * 8192), 16, 0, 0); } while (0)
#define PG8_LDA(dst, b, h) do { _Pragma("unroll") for (int m = 0; m < 4; ++m) _Pragma("unroll") for (int k = 0; k < 2; ++k) dst[m][k] = *(const LAS bf16x8*)(lds + PG8_SA(b, h) + aoff + m * 2048 + k * 1024); } while (0)
#define PG8_LDB(dst, b, h) do { _Pragma("unroll") for (int n = 0; n < 2; ++n) _Pragma("unroll") for (int k = 0; k < 2; ++k) dst[n][k] = *(const LAS bf16x8*)(lds + PG8_SB(b, h) + boff + n * 2048 + k * 1024); } while (0)
#define PG8_MMA(ai, bj, At, Bt) do { __builtin_amdgcn_s_setprio(1); _Pragma("unroll") for (int m = 0; m < 4; ++m) _Pragma("unroll") for (int n = 0; n < 2; ++n) _Pragma("unroll") for (int k = 0; k < 2; ++k) \
        acc[ai][bj][m][n] = __builtin_amdgcn_mfma_f32_16x16x32_bf16(Bt[n][k], At[m][k], acc[ai][bj][m][n], 0, 0, 0); __builtin_amdgcn_s_setprio(0); } while (0)
#define PG8_WAIT_V(n) asm volatile("s_waitcnt vmcnt(" #n ")" ::: "memory")
#define PG8_WAIT_L(n) asm volatile("s_waitcnt lgkmcnt(" #n ")" ::: "memory")
#define PG8_BAR __builtin_amdgcn_s_barrier()
#define PG8_SCHED __builtin_amdgcn_sched_barrier(0)
    Unit cur, nxt; int ui = 0;
    if (!S.next(0, cur)) return;
    f32x4 acc[2][2][4][2];
#pragma unroll
    for (int a = 0; a < 2; ++a)
#pragma unroll
        for (int b = 0; b < 2; ++b)
#pragma unroll
            for (int m = 0; m < 4; ++m)
#pragma unroll
                for (int n = 0; n < 2; ++n) acc[a][b][m][n] = (f32x4){0.f, 0.f, 0.f, 0.f};
    bf16x8 At[4][2], B0[2][2], B1[2][2];
    const char* cA = (const char*)g.A + (size_t)cur.pm * tstep; const char* cB = (const char*)g.Bt + (size_t)cur.pn * tstep;
    if constexpr (SP2) {
        PG8_STAGE(PG8_SB(0, 0), cB + PG8_KO(0), voffB); PG8_STAGE(PG8_SB(0, 1), cB + hstep + PG8_KO(0), voffB); PG8_STAGE(PG8_SA(0, 0), cA + PG8_KO(0), voffA); PG8_STAGE(PG8_SA(0, 1), cA + hstep + PG8_KO(0), voffA);
        if (wr == 1) PG8_BAR;
        PG8_WAIT_V(2); PG8_BAR;
        PG8_STAGE(PG8_SB(1, 0), cB + PG8_KO(1), voffB); PG8_STAGE(PG8_SA(1, 0), cA + PG8_KO(1), voffA); PG8_STAGE(PG8_SB(1, 1), cB + hstep + PG8_KO(1), voffB);
        PG8_WAIT_V(6); PG8_BAR;
    } else {
        PG8_STAGE(PG8_SB(0, 0), cB + PG8_KO(0), voffB); PG8_STAGE(PG8_SA(0, 0), cA + PG8_KO(0), voffA); PG8_STAGE(PG8_SB(0, 1), cB + hstep + PG8_KO(0), voffB); PG8_STAGE(PG8_SA(0, 1), cA + hstep + PG8_KO(0), voffA);
        if (wr == 1) PG8_BAR;
        PG8_WAIT_V(4); PG8_BAR;
        PG8_STAGE(PG8_SB(1, 0), cB + PG8_KO(1), voffB); PG8_STAGE(PG8_SA(1, 0), cA + PG8_KO(1), voffA); PG8_STAGE(PG8_SB(1, 1), cB + hstep + PG8_KO(1), voffB);
        PG8_WAIT_V(6); PG8_BAR;
    }
    for (;;) {
        const bool has_next = S.next(ui + 1, nxt);
        const char* nA = has_next ? (const char*)g.A + (size_t)nxt.pm * tstep : cA; const char* nB = has_next ? (const char*)g.Bt + (size_t)nxt.pn * tstep : cB;
        for (int t = 0; t < nt; t += 2) {
            const bool last = (t == nt - 2);
            const char* a1 = cA + PG8_KO(t + 1);
            const char* a2 = (last ? nA : cA) + PG8_KO(t + 2); const char* b2 = (last ? nB : cB) + PG8_KO(t + 2);
            const char* a3 = (last ? nA : cA) + PG8_KO(t + 3); const char* b3 = (last ? nB : cB) + PG8_KO(t + 3);
            if constexpr (SP2) {
            PG8_LDB(B0, 0, 0); PG8_LDB(B1, 0, 1); PG8_SCHED; PG8_LDA(At, 0, 0); PG8_STAGE(PG8_SA(1, 1), a1 + hstep, voffA);
            PG8_WAIT_V(8); PG8_WAIT_L(0); PG8_BAR; PG8_MMA(0, 0, At, B0); PG8_MMA(0, 1, At, B1); PG8_BAR; PG8_SCHED;
            PG8_LDA(At, 0, 1); PG8_STAGE(PG8_SB(0, 0), b2, voffB); PG8_STAGE(PG8_SB(0, 1), b2 + hstep, voffB); PG8_STAGE(PG8_SA(0, 0), a2, voffA);
            PG8_WAIT_V(8); PG8_WAIT_L(0); PG8_BAR; PG8_MMA(1, 0, At, B0); PG8_MMA(1, 1, At, B1); PG8_BAR; PG8_SCHED;
            PG8_LDB(B0, 1, 0); PG8_LDB(B1, 1, 1); PG8_SCHED; PG8_LDA(At, 1, 0); PG8_STAGE(PG8_SA(0, 1), a2 + hstep, voffA);
            PG8_WAIT_V(8); PG8_WAIT_L(0); PG8_BAR; PG8_MMA(0, 0, At, B0); PG8_MMA(0, 1, At, B1); PG8_BAR; PG8_SCHED;
            PG8_LDA(At, 1, 1); PG8_STAGE(PG8_SB(1, 0), b3, voffB); PG8_STAGE(PG8_SB(1, 1), b3 + hstep, voffB); PG8_STAGE(PG8_SA(1, 0), a3, voffA);
            PG8_WAIT_V(8); PG8_WAIT_L(0); PG8_BAR; PG8_MMA(1, 0, At, B0); PG8_MMA(1, 1, At, B1); PG8_BAR; PG8_SCHED;
            } else {
            PG8_LDB(B0, 0, 0); PG8_SCHED; PG8_LDA(At, 0, 0); PG8_STAGE(PG8_SA(1, 1), a1 + hstep, voffA);
            PG8_WAIT_L(8); PG8_BAR; PG8_WAIT_L(0); PG8_MMA(0, 0, At, B0); PG8_BAR; PG8_SCHED;
            PG8_LDB(B1, 0, 1); PG8_STAGE(PG8_SB(0, 0), b2, voffB);
            PG8_BAR; PG8_WAIT_L(0); PG8_MMA(0, 1, At, B1); PG8_BAR;
            PG8_LDA(At, 0, 1); PG8_STAGE(PG8_SA(0, 0), a2, voffA);
            PG8_BAR; PG8_WAIT_L(0); PG8_MMA(1, 0, At, B0); PG8_BAR; PG8_SCHED;
            PG8_STAGE(PG8_SB(0, 1), b2 + hstep, voffB);
            PG8_WAIT_V(6); PG8_BAR; PG8_MMA(1, 1, At, B1); PG8_BAR;
            PG8_LDB(B0, 1, 0); PG8_SCHED; PG8_LDA(At, 1, 0); PG8_STAGE(PG8_SA(0, 1), a2 + hstep, voffA);
            PG8_WAIT_L(8); PG8_BAR; PG8_WAIT_L(0); PG8_MMA(0, 0, At, B0); PG8_BAR; PG8_SCHED;
            PG8_LDB(B1, 1, 1); PG8_STAGE(PG8_SB(1, 0), b3, voffB);
            PG8_BAR; PG8_WAIT_L(0); PG8_MMA(0, 1, At, B1); PG8_BAR;
            PG8_LDA(At, 1, 1); PG8_STAGE(PG8_SA(1, 0), a3, voffA);
            PG8_BAR; PG8_WAIT_L(0); PG8_MMA(1, 0, At, B0); PG8_BAR; PG8_SCHED;
            PG8_STAGE(PG8_SB(1, 1), b3 + hstep, voffB);
            PG8_WAIT_V(6); PG8_BAR; PG8_MMA(1, 1, At, B1); PG8_BAR;
            }
        }
        if constexpr (ALIGN_EPI) { if (wr == 0) PG8_BAR; }
        E(acc, cur, wr, wc, fr, fq);
        if (!has_next) break;
#pragma unroll
        for (int a = 0; a < 2; ++a)
#pragma unroll
            for (int b = 0; b < 2; ++b)
#pragma unroll
                for (int m = 0; m < 4; ++m)
#pragma unroll
                    for (int n = 0; n < 2; ++n) acc[a][b][m][n] = (f32x4){0.f, 0.f, 0.f, 0.f};
        cur = nxt; cA = nA; cB = nB; ++ui;
        if constexpr (ALIGN_EPI) { if (wr == 1) PG8_BAR; }
    }
    PG8_WAIT_V(0);
    if constexpr (!ALIGN_EPI) { if (wr == 0) PG8_BAR; }
    PG8_BAR;
#undef PG8_KO
#undef PG8_SA
#undef PG8_SB
#undef PG8_STAGE
#undef PG8_LDA
#undef PG8_LDB
#undef PG8_MMA
#undef PG8_WAIT_V
#undef PG8_WAIT_L
#undef PG8_BAR
#undef PG8_SCHED
}
}
using pg8::Unit;
typedef f32x4 AccT[2][2][4][2];

struct Params {
    const float *x, *c, *ctx, *c_ctx, *w_ada, *b_ada, *norm_gain, *w_in, *b_merge, *lb_f, *lb_b, *hg_gain, *w_o_hgrn, *sink, *w_o_attn, *w_out, *fgain;
    float* out; unsigned char* ws;
    int ph_lo, ph_hi;
};

__device__ __forceinline__ int rope_inv(int d) { const int half = d >> 6, dd = d & 63, hi = dd >> 5, r = dd & 31; return ((half * 8 + (r >> 2)) * 8) + hi * 4 + (r & 3); }
__device__ __forceinline__ int dest_row(int c) {
    if (c < 2048) return 7168 + (c & ~127) + rope_inv(c & 127);
    if (c < 2560) { const int cc = c - 2048; return (cc & ~127) + rope_inv(cc & 127); }
    if (c < 3072) return 512 + (c - 2560);
    if (c < 5120) return 11264 + (c - 3072);
    if (c < 7168) return 9216 + (c - 5120);
    if (c < 9216) return 1024 + (c - 7168);
    if (c < 11264) return 3072 + (c - 9216);
    if (c < 13312) return 5120 + (c - 11264);
    return c;
}

__device__ __forceinline__ void transpose_item(const float* W, int K, int N, u16* WT, bool permute, LAS float* scr, int item, int lane) {
    const int nblk = N / 32, kb = item / nblk, nb = item % nblk, k0 = 64 * kb, n0 = 32 * nb;
    float tv[32];
#pragma unroll
    for (int i = 0; i < 32; ++i) { const int kk = 2 * i + (lane >> 5); tv[i] = W[(size_t)(k0 + kk) * N + n0 + (lane & 31)]; }
#pragma unroll
    for (int i = 0; i < 32; ++i) { const int kk = 2 * i + (lane >> 5); scr[kk * 33 + (lane & 31)] = tv[i]; }
    LDS_WAIT();
    const int c = lane & 7;
#pragma unroll
    for (int j = 0; j < 4; ++j) { const int n = (lane >> 3) + 8 * j; const LAS float* s = scr + (8 * c) * 33 + n;
        u32x4 o; o.x = pk2(s[0 * 33], s[1 * 33]); o.y = pk2(s[2 * 33], s[3 * 33]); o.z = pk2(s[4 * 33], s[5 * 33]); o.w = pk2(s[6 * 33], s[7 * 33]);
        const int row = permute ? dest_row(n0 + n) : (n0 + n);
        *(u32x4*)(WT + (size_t)row * K + k0 + 8 * c) = o; }
    LDS_WAIT();
}

__device__ __forceinline__ float wave_sum(float v) {
#pragma unroll
    for (int o = 1; o < 64; o <<= 1) v += __shfl_xor(v, o);
    return v;
}

__device__ __forceinline__ void phase0_mod(const Params& p, int gw, int NGW, int lane) {
    float* mod = (float*)(p.ws + WS_MOD);
    for (int it = gw; it < 64 * 96; it += NGW) {
        const int ks = it / 96, nc = it % 96, k0 = 32 * ks, n = 64 * nc + lane;
        float sv[5];
#pragma unroll
        for (int r = 0; r < 5; ++r) { const float cv = (r < 4) ? p.c[r * D + k0 + (lane & 31)] : p.c_ctx[k0 + (lane & 31)]; sv[r] = siluf_(cv); }
        float acc[5] = {0.f, 0.f, 0.f, 0.f, 0.f};
        const float* wp = p.w_ada + (size_t)k0 * NMOD + n;
#pragma unroll
        for (int kk = 0; kk < 32; ++kk) { const float w = wp[(size_t)kk * NMOD];
#pragma unroll
            for (int r = 0; r < 5; ++r) acc[r] += __shfl(sv[r], kk) * w; }
#pragma unroll
        for (int r = 0; r < 5; ++r) atomicAdd(mod + r * NMOD + n, acc[r]);
    }
}
__device__ __forceinline__ void phase0_tr(const Params& p, LAS unsigned char* lds, int gw, int NGW, int wave, int lane) {
    LAS float* scr = (LAS float*)(lds + wave * 16384);
    constexpr int I_IN = (D / 64) * (NCOL / 32), I_O = (D / 64) * (D / 32);
    for (int it = gw; it < I_IN + 3 * I_O; it += NGW) {
        int r = it;
        if (r < I_IN) { transpose_item(p.w_in, D, NCOL, (u16*)(p.ws + WS_WINT), true, scr, r, lane); continue; } r -= I_IN;
        if (r < I_O) { transpose_item(p.w_o_hgrn, D, D, (u16*)(p.ws + WS_WH), false, scr, r, lane); continue; } r -= I_O;
        if (r < I_O) { transpose_item(p.w_o_attn, D, D, (u16*)(p.ws + WS_WA), false, scr, r, lane); continue; } r -= I_O;
        transpose_item(p.w_out, D, D, (u16*)(p.ws + WS_WO), false, scr, r, lane);
    }
}

__device__ __forceinline__ void phase1(const Params& p, int gw, int NGW, int lane) {
    const float* mod = (const float*)(p.ws + WS_MOD);
    u16* XN = (u16*)(p.ws + WS_XN);
    for (int rowa = gw; rowa < MTOT; rowa += 2 * NGW) {
        const int rowb = (rowa + NGW < MTOT) ? rowa + NGW : rowa;
        const float* srca = (rowa < M) ? p.x + (size_t)rowa * D : p.ctx + (size_t)(rowa - M) * D;
        const float* srcb = (rowb < M) ? p.x + (size_t)rowb * D : p.ctx + (size_t)(rowb - M) * D;
        f32x4 va[8], vb[8]; float sa_ = 0.f, sb_ = 0.f;
#pragma unroll
        for (int j = 0; j < 8; ++j) { va[j] = ((const f32x4*)srca)[lane + 64 * j]; vb[j] = ((const f32x4*)srcb)[lane + 64 * j]; }
#pragma unroll
        for (int j = 0; j < 8; ++j) { sa_ += (va[j].x * va[j].x + va[j].y * va[j].y) + (va[j].z * va[j].z + va[j].w * va[j].w); sb_ += (vb[j].x * vb[j].x + vb[j].y * vb[j].y) + (vb[j].z * vb[j].z + vb[j].w * vb[j].w); }
        const float rsa = __builtin_amdgcn_rsqf(wave_sum(sa_) * (1.f / D) + EPS), rsb = __builtin_amdgcn_rsqf(wave_sum(sb_) * (1.f / D) + EPS);
        const int ra = (rowa < M) ? (rowa / T) : 4, rb = (rowb < M) ? (rowb / T) : 4;
#pragma unroll
        for (int j = 0; j < 8; ++j) {
            const int c = 4 * (lane + 64 * j);
            const f32x4 g = *(const f32x4*)(p.norm_gain + c);
            const f32x4 bsh = *(const f32x4*)(p.b_ada + c), bsc = *(const f32x4*)(p.b_ada + D + c);
            { const f32x4 sh = *(const f32x4*)(mod + ra * NMOD + c) + bsh; const f32x4 sc = *(const f32x4*)(mod + ra * NMOD + D + c) + bsc;
              const f32x4 y = (va[j] * rsa) * g * (sc + 1.f) + sh; u32x2 o; o.x = pk2(y.x, y.y); o.y = pk2(y.z, y.w); *(u32x2*)(XN + (size_t)rowa * D + c) = o; }
            if (rowb != rowa) { const f32x4 sh = *(const f32x4*)(mod + rb * NMOD + c) + bsh; const f32x4 sc = *(const f32x4*)(mod + rb * NMOD + D + c) + bsc;
              const f32x4 y = (vb[j] * rsb) * g * (sc + 1.f) + sh; u32x2 o; o.x = pk2(y.x, y.y); o.y = pk2(y.z, y.w); *(u32x2*)(XN + (size_t)rowb * D + c) = o; }
        }
    }
}

#define EPI_V8(acc, ai, bj, m, v) float v[8]; { const f32x4 _a = acc[ai][bj][m][0], _b = acc[ai][bj][m][1]; v[0] = _a.x; v[1] = _a.y; v[2] = _a.z; v[3] = _a.w; v[4] = _b.x; v[5] = _b.y; v[6] = _b.z; v[7] = _b.w; }
__device__ __forceinline__ u32x4 pack8(const float* v) { u32x4 o; o.x = pk2(v[0], v[1]); o.y = pk2(v[2], v[3]); o.z = pk2(v[4], v[5]); o.w = pk2(v[6], v[7]); return o; }
__device__ __forceinline__ u32x4 pack8h(const float* v) { u32x4 o; o.x = pkh2(v[0], v[1]); o.y = pkh2(v[2], v[3]); o.z = pkh2(v[4], v[5]); o.w = pkh2(v[6], v[7]); return o; }

struct EpiIn {
    unsigned char* ws; const float* lbf; const float* lbb; const float* bm; u16* sg;
    __device__ __forceinline__ void operator()(const AccT& acc, const Unit& u, int wr, int wc, int fr, int fq) const {
        const int pn = u.pn; const bool isctx = u.pm >= 64;
        const int row0 = u.pm * 256 + wr * 64 + fr;
        const int cw = 32 * wc + 8 * fq;
        if (pn >= 60) {
            const int grp = (pn - 60) >> 3; const int colbase = ((pn - 60) & 7) * 256;
            u16* base = sg + (size_t)grp * M * D;
#pragma unroll
            for (int ai = 0; ai < 2; ++ai)
#pragma unroll
                for (int m = 0; m < 4; ++m) {
                    const int row = row0 + 128 * ai + 16 * m;
#pragma unroll
                    for (int bj = 0; bj < 2; ++bj) {
                        EPI_V8(acc, ai, bj, m, v);
                        const int c = colbase + 128 * bj + cw;
                        const float* bp = bm + grp * D + c;
                        const f32x4 b0 = *(const f32x4*)bp, b1 = *(const f32x4*)(bp + 4);
                        v[0] = sigmoidf_(v[0] + b0.x); v[1] = sigmoidf_(v[1] + b0.y); v[2] = sigmoidf_(v[2] + b0.z); v[3] = sigmoidf_(v[3] + b0.w);
                        v[4] = sigmoidf_(v[4] + b1.x); v[5] = sigmoidf_(v[5] + b1.y); v[6] = sigmoidf_(v[6] + b1.z); v[7] = sigmoidf_(v[7] + b1.w);
                        *(u32x4*)(base + (size_t)row * D + c) = pack8(v);
                    }
                }
        } else if (pn < 2 || (pn >= 28 && pn < 36)) {
            const bool isq = pn >= 28;
            const int g = cw >> 3;
            const int axis = g >> 3; const int f0 = (g & 7) * 4;
            float invf[4];
#pragma unroll
            for (int e = 0; e < 4; ++e) invf[e] = fexp2(-(float)(f0 + e) * 0.41524101186092029f) * 0.15915494309189535f;
            const float qs = isq ? (0.08838834764831845f * LOG2E) : 1.f;
            u16* base; int ld, colbase;
            if (isq) { base = (u16*)(ws + WS_Q); ld = D; colbase = (pn - 28) * 256; }
            else if (!isctx) { base = (u16*)(ws + WS_K); ld = 512; colbase = pn * 256; }
            else { base = (u16*)(ws + WS_KC); ld = 512; colbase = pn * 256; }
#pragma unroll
            for (int ai = 0; ai < 2; ++ai)
#pragma unroll
                for (int m = 0; m < 4; ++m) {
                    const int row = row0 + 128 * ai + 16 * m;
                    const int orow = isctx ? row - M : row;
                    const int t = row & (T - 1);
                    const float pos = (float)(axis ? (t & 63) : (t >> 6));
                    float cs[4], sn[4];
#pragma unroll
                    for (int e = 0; e < 4; ++e) { const float rev = pos * invf[e]; cs[e] = isctx ? 1.f : __builtin_amdgcn_cosf(rev); sn[e] = isctx ? 0.f : __builtin_amdgcn_sinf(rev); }
#pragma unroll
                    for (int bj = 0; bj < 2; ++bj) {
                        EPI_V8(acc, ai, bj, m, v);
                        float o[8];
#pragma unroll
                        for (int e = 0; e < 4; ++e) { o[e] = (v[e] * cs[e] - v[4 + e] * sn[e]) * qs; o[4 + e] = (v[4 + e] * cs[e] + v[e] * sn[e]) * qs; }
                        *(u32x4*)(base + (size_t)orow * ld + colbase + 128 * bj + cw) = pack8(o);
                    }
                }
        } else if (pn < 4) {
#pragma unroll
            for (int ai = 0; ai < 2; ++ai)
#pragma unroll
                for (int m = 0; m < 4; ++m) {
                    const int row = row0 + 128 * ai + 16 * m;
#pragma unroll
                    for (int bj = 0; bj < 2; ++bj) {
                        EPI_V8(acc, ai, bj, m, v);
                        const int kvh = (pn - 2) * 2 + bj;
                        u16* dst;
                        if (!isctx) { const int b = row >> 12, t = row & (T - 1); dst = (u16*)(ws + WS_VT) + ((size_t)((b * 4 + kvh) * 128 + cw)) * T + t;
#pragma unroll
                            for (int e = 0; e < 8; ++e) dst[(size_t)e * T] = (u16)(pk2(v[e], 0.f) & 0xffffu);
                        } else { const int rr = row - M, b = rr >> 8, t = rr & (LC - 1); dst = (u16*)(ws + WS_VCT) + ((size_t)((b * 4 + kvh) * 128 + cw)) * LC + t;
#pragma unroll
                            for (int e = 0; e < 8; ++e) dst[(size_t)e * LC] = (u16)(pk2(v[e], 0.f) & 0xffffu);
                        }
                    }
                }
        } else if (pn < 20) {
            const bool bwd = pn >= 12;
            const float* lbl = bwd ? lbb : lbf;
            const int colbase = (pn - (bwd ? 12 : 4)) * 256;
            u16* base = (u16*)(ws + (isctx ? (bwd ? WS_CFB : WS_CFF) : (bwd ? WS_LFB : WS_LFF)));
            float lb[2][8];
#pragma unroll
            for (int bj = 0; bj < 2; ++bj)
#pragma unroll
                for (int e = 0; e < 8; ++e) { const int c = colbase + 128 * bj + cw + e; lb[bj][e] = __builtin_amdgcn_rcpf(1.f + fexp2((lbl[D + c] - lbl[c]) * LOG2E)); }
#pragma unroll
            for (int ai = 0; ai < 2; ++ai)
#pragma unroll
                for (int m = 0; m < 4; ++m) {
                    const int row = row0 + 128 * ai + 16 * m; const int orow = isctx ? row - M : row;
#pragma unroll
                    for (int bj = 0; bj < 2; ++bj) {
                        EPI_V8(acc, ai, bj, m, v);
                        float o[8];
#pragma unroll
                        for (int e = 0; e < 8; ++e) o[e] = (1.f - lb[bj][e]) * sigmoidf_(-v[e]);
                        *(u32x4*)(base + (size_t)orow * D + colbase + 128 * bj + cw) = pack8h(o);
                    }
                }
        } else {
            const bool ishq = pn >= 36;
            const int colbase = (pn - (ishq ? 36 : 20)) * 256;
            u16* base = (u16*)(ws + (ishq ? WS_QH : (isctx ? WS_CI : WS_VH)));
#pragma unroll
            for (int ai = 0; ai < 2; ++ai)
#pragma unroll
                for (int m = 0; m < 4; ++m) {
                    const int row = row0 + 128 * ai + 16 * m; const int orow = isctx ? row - M : row;
#pragma unroll
                    for (int bj = 0; bj < 2; ++bj) {
                        EPI_V8(acc, ai, bj, m, v);
                        if (ishq) {
#pragma unroll
                            for (int e = 0; e < 8; ++e) v[e] = siluf_(v[e]);
                        }
                        *(u32x4*)(base + (size_t)orow * D + colbase + 128 * bj + cw) = pack8(v);
                    }
                }
        }
    }
};

struct EpiGate {
    unsigned char* ws; const float* hgain; LAS unsigned char* lds;
    __device__ __forceinline__ void operator()(const AccT& acc, const Unit& u, int wr, int wc, int fr, int fq) const {
        const int grp = u.pn >> 3; const int colbase = (u.pn & 7) * 256;
        const int row0 = u.pm * 256 + wr * 64 + fr; const int cw = 32 * wc + 8 * fq;
        if (grp == 0) {
            u16* base = (u16*)(ws + WS_Q);
#pragma unroll
            for (int ai = 0; ai < 2; ++ai)
#pragma unroll
                for (int m = 0; m < 4; ++m) {
                    const int row = row0 + 128 * ai + 16 * m;
#pragma unroll
                    for (int bj = 0; bj < 2; ++bj) {
                        EPI_V8(acc, ai, bj, m, v);
                        u16* dst = base + (size_t)row * D + colbase + 128 * bj + cw;
                        const u32x4 in = *(const u32x4*)dst;
                        v[0] = siluf_(v[0]) * bflo(in.x); v[1] = siluf_(v[1]) * bfhi(in.x); v[2] = siluf_(v[2]) * bflo(in.y); v[3] = siluf_(v[3]) * bfhi(in.y);
                        v[4] = siluf_(v[4]) * bflo(in.z); v[5] = siluf_(v[5]) * bfhi(in.z); v[6] = siluf_(v[6]) * bflo(in.w); v[7] = siluf_(v[7]) * bfhi(in.w);
                        *(u32x4*)dst = pack8(v);
                    }
                }
        } else {
            const u16* OFh = (const u16*)(ws + WS_LFF); const u16* OBh = (const u16*)(ws + WS_LFB); u16* OB = (u16*)(ws + WS_OB);
            LAS float* ssb = (LAS float*)(lds + LDS_SSB);
#pragma unroll
            for (int ai = 0; ai < 2; ++ai) {
                unsigned xs[4][2][4];
#pragma unroll
                for (int m = 0; m < 4; ++m)
#pragma unroll
                    for (int bj = 0; bj < 2; ++bj) {
                        const size_t idx = (size_t)(row0 + 128 * ai + 16 * m) * D + colbase + 128 * bj + cw;
                        const u32x4 a = *(const u32x4*)(OFh + idx), b = *(const u32x4*)(OBh + idx);
                        float ss = 0.f;
#pragma unroll
                        for (int e = 0; e < 4; ++e) { const float x0 = h2f((u16)(a[e] & 0xffffu)) + h2f((u16)(b[e] & 0xffffu)), x1 = h2f((u16)(a[e] >> 16)) + h2f((u16)(b[e] >> 16)); ss += x0 * x0 + x1 * x1; xs[m][bj][e] = pkh2(x0, x1); }
                        ss += __shfl_xor(ss, 16); ss += __shfl_xor(ss, 32);
                        if (fq == 0) atomicAdd((float*)(ssb + (128 * ai + 64 * wr + 16 * m + fr) * 2 + bj), ss);
                    }
                BAR_LDS();
#pragma unroll
                for (int m = 0; m < 4; ++m)
#pragma unroll
                    for (int bj = 0; bj < 2; ++bj) {
                        EPI_V8(acc, ai, bj, m, v);
                        const size_t idx = (size_t)(row0 + 128 * ai + 16 * m) * D + colbase + 128 * bj + cw;
                        const float rstd = __builtin_amdgcn_rsqf(ssb[(128 * ai + 64 * wr + 16 * m + fr) * 2 + bj] * (1.f / 128.f) + EPS);
                        const float* gp = hgain + colbase + 128 * bj + cw; const f32x4 ga = *(const f32x4*)gp, gb = *(const f32x4*)(gp + 4);
                        const float g8[8] = {ga.x, ga.y, ga.z, ga.w, gb.x, gb.y, gb.z, gb.w};
#pragma unroll
                        for (int e = 0; e < 4; ++e) { const unsigned xp = xs[m][bj][e]; const float x0 = h2f((u16)(xp & 0xffffu)), x1 = h2f((u16)(xp >> 16));
                            v[2 * e] = siluf_(v[2 * e]) * (x0 * rstd * g8[2 * e]); v[2 * e + 1] = siluf_(v[2 * e + 1]) * (x1 * rstd * g8[2 * e + 1]); }
                        *(u32x4*)(OB + idx) = pack8(v);
                    }
                asm volatile("" ::: "memory");
            }
            BAR_LDS();
            if (fq == 0 && wc == 0) {
#pragma unroll
                for (int ai = 0; ai < 2; ++ai)
#pragma unroll
                    for (int m = 0; m < 4; ++m) { ssb[(128 * ai + 64 * wr + 16 * m + fr) * 2] = 0.f; ssb[(128 * ai + 64 * wr + 16 * m + fr) * 2 + 1] = 0.f; }
            }
        }
    }
};

template <int MODE> struct EpiMerge {
    unsigned char* ws; float* tmp; const u16* sgate;
    __device__ __forceinline__ void operator()(const AccT& acc, const Unit& u, int wr, int wc, int fr, int fq) const {
        const int colbase = u.pn * 256; const int row0 = u.pm * 256 + wr * 64 + fr; const int cw = 32 * wc + 8 * fq;
        const u16* sg = sgate + (size_t)MODE * M * D;
        u16* Y = (u16*)(ws + WS_QH);
#pragma unroll
        for (int ai = 0; ai < 2; ++ai)
#pragma unroll
            for (int m = 0; m < 4; ++m) {
                const int row = row0 + 128 * ai + 16 * m;
#pragma unroll
                for (int bj = 0; bj < 2; ++bj) {
                    EPI_V8(acc, ai, bj, m, v);
                    const size_t idx = (size_t)row * D + colbase + 128 * bj + cw;
                    const u32x4 s = *(const u32x4*)(sg + idx);
                    v[0] *= bflo(s.x); v[1] *= bfhi(s.x); v[2] *= bflo(s.y); v[3] *= bfhi(s.y); v[4] *= bflo(s.z); v[5] *= bfhi(s.z); v[6] *= bflo(s.w); v[7] *= bfhi(s.w);
                    if (MODE == 0) { *(f32x4*)(tmp + idx) = (f32x4){v[0], v[1], v[2], v[3]}; *(f32x4*)(tmp + idx + 4) = (f32x4){v[4], v[5], v[6], v[7]}; }
                    else { const f32x4 t0 = *(const f32x4*)(tmp + idx), t1 = *(const f32x4*)(tmp + idx + 4);
                        v[0] += t0.x; v[1] += t0.y; v[2] += t0.z; v[3] += t0.w; v[4] += t1.x; v[5] += t1.y; v[6] += t1.z; v[7] += t1.w;
                        *(u32x4*)(Y + idx) = pack8(v); }
                }
            }
    }
};

struct EpiOut {
    const float* x; const float* mod; const float* b_ada; float* out; float* rss;
    __device__ __forceinline__ void operator()(const AccT& acc, const Unit& u, int wr, int wc, int fr, int fq) const {
        const int colbase = u.pn * 256; const int row0 = u.pm * 256 + wr * 64 + fr; const int cw = 32 * wc + 8 * fq;
        const int b = u.pm >> 4;
        float gt[2][8];
#pragma unroll
        for (int bj = 0; bj < 2; ++bj)
#pragma unroll
            for (int e = 0; e < 8; ++e) { const int c = colbase + 128 * bj + cw + e; gt[bj][e] = mod[b * NMOD + 2 * D + c] + b_ada[2 * D + c]; }
#pragma unroll
        for (int ai = 0; ai < 2; ++ai)
#pragma unroll
            for (int m = 0; m < 4; ++m) {
                const int row = row0 + 128 * ai + 16 * m; float ss = 0.f;
#pragma unroll
                for (int bj = 0; bj < 2; ++bj) {
                    EPI_V8(acc, ai, bj, m, v);
                    const size_t idx = (size_t)row * D + colbase + 128 * bj + cw;
                    const f32x4 x0 = *(const f32x4*)(x + idx), x1 = *(const f32x4*)(x + idx + 4);
                    f32x4 h0, h1;
                    h0.x = x0.x + gt[bj][0] * v[0]; h0.y = x0.y + gt[bj][1] * v[1]; h0.z = x0.z + gt[bj][2] * v[2]; h0.w = x0.w + gt[bj][3] * v[3];
                    h1.x = x1.x + gt[bj][4] * v[4]; h1.y = x1.y + gt[bj][5] * v[5]; h1.z = x1.z + gt[bj][6] * v[6]; h1.w = x1.w + gt[bj][7] * v[7];
                    ss += (h0.x * h0.x + h0.y * h0.y) + (h0.z * h0.z + h0.w * h0.w) + (h1.x * h1.x + h1.y * h1.y) + (h1.z * h1.z + h1.w * h1.w);
                    *(f32x4*)(out + idx) = h0; *(f32x4*)(out + idx + 4) = h1;
                }
                ss += __shfl_xor(ss, 16); ss += __shfl_xor(ss, 32);
                if (fq == 0) atomicAdd(rss + row, ss);
            }
    }
};

constexpr int AK_LD = 136, AV_LD = 72;
constexpr int ATT_BUF = (64 * AK_LD + 128 * AV_LD) * 2;
__device__ __forceinline__ void attn_unit(const Params& p, LAS unsigned char* lds, int unit, int tid) {
    const int hp = unit & 1, kvh = (unit >> 1) & 3, qb = (unit >> 3) & 31, b = unit >> 8;
    const int wave = tid >> 6, lane = tid & 63, r = lane & 31, h = lane >> 5;
    const int head = kvh * 4 + hp * 2 + (wave >> 2);
    const int tq = qb * 128 + (wave & 3) * 32 + r;
    u16* Q = (u16*)(p.ws + WS_Q);
    const u16* Kb = (const u16*)(p.ws + WS_K); const u16* VTb = (const u16*)(p.ws + WS_VT);
    const u16* KC = (const u16*)(p.ws + WS_KC); const u16* VCT = (const u16*)(p.ws + WS_VCT);
    bf16x8 qf[8];
    { const u16* qp = Q + ((size_t)(b * T + tq)) * D + head * 128 + 8 * h;
#pragma unroll
      for (int s = 0; s < 8; ++s) qf[s] = *(const bf16x8*)(qp + 16 * s); }
    float m_run = p.sink[head] * LOG2E; float l_run = (h == 0) ? 1.f : 0.f;
    f32x16 o[4];
#pragma unroll
    for (int mt = 0; mt < 4; ++mt)
#pragma unroll
        for (int i = 0; i < 16; ++i) o[mt][i] = 0.f;
    const int jb = (qb == 0) ? 2 : 0, je = (qb == 31) ? 4 : 6, nw = je - jb, ntile = nw + 4;
    u32x4 kreg[2], vreg[2];
#define ATT_LOAD(i) do { const int _i = (i); const u16* ks; const u16* vs; size_t vld; \
        if (_i < nw) { const int key0 = qb * 128 - 128 + 64 * (jb + _i); ks = Kb + ((size_t)(b * T + key0)) * 512 + kvh * 128; vs = VTb + ((size_t)((b * 4 + kvh) * 128)) * T + key0; vld = T; } \
        else { const int key0 = 64 * (_i - nw); ks = KC + ((size_t)(b * LC + key0)) * 512 + kvh * 128; vs = VCT + ((size_t)((b * 4 + kvh) * 128)) * LC + key0; vld = LC; } \
        _Pragma("unroll") for (int _j = 0; _j < 2; ++_j) { const int ch = tid + 512 * _j; \
            kreg[_j] = *(const u32x4*)(ks + (size_t)(ch >> 4) * 512 + (ch & 15) * 8); \
            vreg[_j] = *(const u32x4*)(vs + (size_t)(ch >> 3) * vld + (ch & 7) * 8); } } while (0)
#define ATT_STORE(bufi) do { LAS u16* kt = (LAS u16*)(lds + (bufi) * ATT_BUF); LAS u16* vt = kt + 64 * AK_LD; \
        _Pragma("unroll") for (int _j = 0; _j < 2; ++_j) { const int ch = tid + 512 * _j; \
            *(LAS u32x4*)(kt + (ch >> 4) * AK_LD + (ch & 15) * 8) = kreg[_j]; \
            LAS u16* vrow = vt + (ch >> 3) * AV_LD + ((ch & 7) >> 1) * 16 + ((ch & 1) ? 4 : 0);     \
            *(LAS u32x2*)vrow = (u32x2){vreg[_j].x, vreg[_j].y}; *(LAS u32x2*)(vrow + 8) = (u32x2){vreg[_j].z, vreg[_j].w}; } } while (0)
    ATT_LOAD(0); ATT_STORE(0);
    __syncthreads();
    for (int it = 0; it < ntile; ++it) {
        if (it + 1 < ntile) ATT_LOAD(it + 1);
        const LAS u16* kt = (const LAS u16*)(lds + (it & 1) * ATT_BUF); const LAS u16* vt = kt + 64 * AK_LD;
        int cls = 2; int key0 = 0;
        if (it < nw) { key0 = qb * 128 - 128 + 64 * (jb + it); const int q0 = qb * 128 + (wave & 3) * 32;
            if (key0 + 63 < q0 - 128 || key0 > q0 + 31 + 128) cls = 0;
            else if (key0 < q0 + 31 - 128 || key0 + 63 > q0 + 128) cls = 1; }
        if (cls != 0) {
        f32x16 sa[2];
        __builtin_amdgcn_s_setprio(1);
#pragma unroll
        for (int k2 = 0; k2 < 2; ++k2) {
#pragma unroll
            for (int i = 0; i < 16; ++i) sa[k2][i] = 0.f;
#pragma unroll
            for (int s = 0; s < 8; ++s) { const bf16x8 kf = *(const LAS bf16x8*)(kt + (32 * k2 + r) * AK_LD + 16 * s + 8 * h); sa[k2] = MFMA32(kf, qf[s], sa[k2]); }
        }
        __builtin_amdgcn_s_setprio(0);
        if (cls == 1) {
#pragma unroll
            for (int k2 = 0; k2 < 2; ++k2)
#pragma unroll
                for (int i = 0; i < 16; ++i) { const int dk = tq - (key0 + 32 * k2 + crow(i, h)); if (dk > 128 || dk < -128) sa[k2][i] = -INFINITY; }
        }
        float tmax = sa[0][0];
#pragma unroll
        for (int k2 = 0; k2 < 2; ++k2)
#pragma unroll
            for (int i = 0; i < 16; ++i) tmax = fmaxf(tmax, sa[k2][i]);
        tmax = fmaxf(tmax, __shfl_xor(tmax, 32));
        if (__builtin_amdgcn_ballot_w64(tmax > m_run + 8.f) != 0ull) {
            const float m_new = fmaxf(m_run, tmax); const float alpha = fexp2(m_run - m_new); m_run = m_new;
            l_run *= alpha;
#pragma unroll
            for (int mt = 0; mt < 4; ++mt)
#pragma unroll
                for (int i = 0; i < 16; ++i) o[mt][i] *= alpha;
        }
        float lsum = 0.f;
#pragma unroll
        for (int k2 = 0; k2 < 2; ++k2)
#pragma unroll
            for (int i = 0; i < 16; ++i) { const float pe = fexp2(sa[k2][i] - m_run); sa[k2][i] = pe; lsum += pe; }
        l_run += lsum;
        __builtin_amdgcn_s_setprio(1);
#pragma unroll
        for (int k2 = 0; k2 < 2; ++k2)
#pragma unroll
            for (int s2 = 0; s2 < 2; ++s2) {
                u32x4 pk; pk.x = pk2(sa[k2][8 * s2 + 0], sa[k2][8 * s2 + 1]); pk.y = pk2(sa[k2][8 * s2 + 2], sa[k2][8 * s2 + 3]);
                pk.z = pk2(sa[k2][8 * s2 + 4], sa[k2][8 * s2 + 5]); pk.w = pk2(sa[k2][8 * s2 + 6], sa[k2][8 * s2 + 7]);
                const bf16x8 pf = __builtin_bit_cast(bf16x8, pk);
#pragma unroll
                for (int mt = 0; mt < 4; ++mt) {
                    const u32x4 vv = *(const LAS u32x4*)(vt + (32 * mt + r) * AV_LD + 32 * k2 + 16 * s2 + 8 * h);
                    o[mt] = MFMA32(__builtin_bit_cast(bf16x8, vv), pf, o[mt]);
                }
            }
        __builtin_amdgcn_s_setprio(0);
        }
        if (it + 1 < ntile) ATT_STORE((it + 1) & 1);
        __syncthreads();
    }
    const float ltot = l_run + __shfl_xor(l_run, 32); const float inv = 1.f / ltot;
    u16* op = Q + ((size_t)(b * T + tq)) * D + head * 128;
#pragma unroll
    for (int mt = 0; mt < 4; ++mt)
#pragma unroll
        for (int q4 = 0; q4 < 4; ++q4) {
            u32x2 w; w.x = pk2(o[mt][4 * q4 + 0] * inv, o[mt][4 * q4 + 1] * inv); w.y = pk2(o[mt][4 * q4 + 2] * inv, o[mt][4 * q4 + 3] * inv);
            *(u32x2*)(op + 32 * mt + 8 * q4 + 4 * h) = w;
        }
#undef ATT_LOAD
#undef ATT_STORE
}

constexpr int HG_QH_LD = 136, HG_LD = 40;
constexpr int HG_OFF_QH = 0, HG_OFF_KHT = 32 * HG_QH_LD * 2, HG_OFF_VT = HG_OFF_KHT + 128 * HG_LD * 2, HG_OFF_AP = HG_OFF_VT + 128 * HG_LD * 2, HG_OFF_DEC = HG_OFF_AP + 4 * 32 * HG_LD * 2;
constexpr int HG_BUF = HG_OFF_DEC + 512;
constexpr int HG_PRIV = 2 * HG_BUF;
constexpr int NSTEP = 8 + 128;
constexpr int HG_RAW = HG_PRIV + 4 * 2 * 32 * HG_LD * 2, HG_RAW_A = 33 * 64, HG_RAW_W = 3 * HG_RAW_A;
static_assert(HG_RAW + 4 * HG_RAW_W <= LDS_BYTES, "hgrn lds");

__device__ __forceinline__ void hgrn_unit(const Params& p, LAS unsigned char* lds, int unit, int tid) {
    const int dir = unit & 1, hh = (unit >> 1) & 15, b = unit >> 5;
    const int wave = tid >> 6, lane = tid & 63, r = lane & 31, h = lane >> 5;
    const u16* LF = (const u16*)(p.ws + (dir ? WS_LFB : WS_LFF)); const u16* CLF = (const u16*)(p.ws + (dir ? WS_CFB : WS_CFF));
    const u16* QHg = (const u16*)(p.ws + WS_QH); const u16* VHg = (const u16*)(p.ws + WS_VH); const u16* CIg = (const u16*)(p.ws + WS_CI);
    u16* OUTg = (u16*)(p.ws + (dir ? WS_LFB : WS_LFF));
    if (wave >= 4) {
        const int pw = wave - 4;
        LAS u16* QTp = (LAS u16*)(lds + HG_PRIV + pw * (2 * 32 * HG_LD * 2)); LAS u16* KHp = QTp + 32 * HG_LD;
        LAS unsigned char* RAW = lds + HG_RAW + pw * HG_RAW_W;
        const int li = lane >> 2, lc4 = lane & 3;
        const int gcol = hh * 128 + 32 * pw + 8 * lc4;
        u32x4 R0[6], R1[6];
#define HG_LOAD(RS, s) do { const int _s = ((s) < NSTEP) ? (s) : (NSTEP - 1); const bool _ctx = _s < 8; const int _cc = _ctx ? _s : _s - 8; const int _TL = _ctx ? LC : T; \
        const u16* _lf = _ctx ? CLF : LF; const u16* _vs = _ctx ? CIg : VHg; const u16* _qs = _ctx ? CIg : QHg; const unsigned _qm = _ctx ? 0u : 0xffffffffu; \
        _Pragma("unroll") for (int jj = 0; jj < 2; ++jj) { const int pos = 32 * _cc + li + 16 * jj; const int t = dir ? (_TL - 1 - pos) : pos; const size_t idx = ((size_t)(b * _TL + t)) * D + gcol; \
            RS[jj] = *(const u32x4*)(_lf + idx); RS[2 + jj] = *(const u32x4*)(_vs + idx); const u32x4 _q = *(const u32x4*)(_qs + idx); RS[4 + jj] = (u32x4){_q.x & _qm, _q.y & _qm, _q.z & _qm, _q.w & _qm}; } } while (0)
#define HG_BUILD(RS, s) do { const int _sb = (s); \
        LAS unsigned char* buf = lds + (_sb & 1) * HG_BUF; \
        _Pragma("unroll") for (int jj = 0; jj < 2; ++jj) { const int ro = (li + 16 * jj) * 64 + jj * 64 + lc4 * 16; \
            *(LAS u32x4*)(RAW + ro) = RS[jj]; *(LAS u32x4*)(RAW + HG_RAW_A + ro) = RS[2 + jj]; *(LAS u32x4*)(RAW + 2 * HG_RAW_A + ro) = RS[4 + jj]; } \
        LDS_WAIT(); \
        HG_LOAD(RS, _sb + 2); \
        float kkv[16], P[16]; u16 qv[16], vv[16]; float run = 1.f; \
        _Pragma("unroll") for (int ii = 0; ii < 16; ++ii) { const int ro = (16 * h + ii) * 64 + h * 64 + 2 * r; \
            kkv[ii] = h2f(*(const LAS u16*)(RAW + ro)); vv[ii] = *(const LAS u16*)(RAW + HG_RAW_A + ro); qv[ii] = *(const LAS u16*)(RAW + 2 * HG_RAW_A + ro); } \
        _Pragma("unroll") for (int ii = 0; ii < 16; ++ii) { run *= (1.f - kkv[ii]); P[ii] = run; } \
        const float oth = __shfl_xor(run, 32); const float Et = run * oth; const float invE = __builtin_amdgcn_rcpf(Et); \
        const float preoff = h ? oth : 1.f; const float sufoff = h ? 1.f : oth; \
        unsigned khp[8], vpk[8]; float suf = sufoff; \
        _Pragma("unroll") for (int ii = 15; ii >= 0; --ii) { \
            const float q = bf2f(qv[ii]); const float qhv = q * (P[ii] * preoff); const float khv = kkv[ii] * suf; const float qtv = qhv * invE; \
            suf *= (1.f - kkv[ii]); \
            const int i = 16 * h + ii; \
            ((LAS u16*)(buf + HG_OFF_QH))[i * HG_QH_LD + 32 * pw + r] = (u16)(pk2(qhv, 0.f) & 0xffffu); \
            QTp[i * HG_LD + r] = (u16)(pk2(qtv, 0.f) & 0xffffu); \
            const unsigned kb = pk2(khv, 0.f) & 0xffffu; \
            KHp[i * HG_LD + r] = (u16)kb; \
            if (ii & 1) { khp[ii >> 1] = kb << 16; vpk[ii >> 1] = ((unsigned)vv[ii]) << 16; } else { khp[ii >> 1] |= kb; vpk[ii >> 1] |= (unsigned)vv[ii]; } } \
        { LAS u32x4* kd = (LAS u32x4*)((LAS u16*)(buf + HG_OFF_KHT) + (32 * pw + r) * HG_LD + 16 * h); \
          kd[0] = (u32x4){khp[0], khp[1], khp[2], khp[3]}; kd[1] = (u32x4){khp[4], khp[5], khp[6], khp[7]}; \
          LAS u32x4* vd = (LAS u32x4*)((LAS u16*)(buf + HG_OFF_VT) + (32 * pw + r) * HG_LD + 16 * h); \
          vd[0] = (u32x4){vpk[0], vpk[1], vpk[2], vpk[3]}; vd[1] = (u32x4){vpk[4], vpk[5], vpk[6], vpk[7]}; \
          if (h == 0) ((LAS float*)(buf + HG_OFF_DEC))[32 * pw + r] = Et; } \
        LDS_WAIT(); \
        f32x16 a; \
        _Pragma("unroll") for (int i = 0; i < 16; ++i) a[i] = 0.f; \
        _Pragma("unroll") for (int s2 = 0; s2 < 2; ++s2) { const bf16x8 af = *(const LAS bf16x8*)(KHp + r * HG_LD + 16 * s2 + 8 * h); const bf16x8 bfg = *(const LAS bf16x8*)(QTp + r * HG_LD + 16 * s2 + 8 * h); a = MFMA32(af, bfg, a); } \
        LAS u16* ap = (LAS u16*)(buf + HG_OFF_AP) + (pw * 32 + r) * HG_LD; \
        _Pragma("unroll") for (int q4 = 0; q4 < 4; ++q4) { float w[4]; \
            _Pragma("unroll") for (int e = 0; e < 4; ++e) { const int j = 8 * q4 + 4 * h + e; w[e] = (j <= r) ? a[4 * q4 + e] : 0.f; } \
            *(LAS u32x2*)(ap + 8 * q4 + 4 * h) = (u32x2){pk2(w[0], w[1]), pk2(w[2], w[3])}; } } while (0)
        __builtin_amdgcn_s_setprio(1);
        HG_LOAD(R0, 0); HG_LOAD(R1, 1);
        for (int s = 0; s < NSTEP; s += 2) {
            HG_BUILD(R0, s);
            BAR_LDS();
            HG_BUILD(R1, s + 1);
            BAR_LDS();
        }
        BAR_LDS();
        __builtin_amdgcn_s_setprio(0);
#undef HG_LOAD
#undef HG_BUILD
    } else {
        const int n = wave;
        f32x16 S[4];
#pragma unroll
        for (int kt = 0; kt < 4; ++kt)
#pragma unroll
            for (int i = 0; i < 16; ++i) S[kt][i] = 0.f;
        for (int s = 0; s <= NSTEP; ++s) {
            if (s >= 1) {
                const int cs = s - 1;
                const LAS unsigned char* buf = lds + (cs & 1) * HG_BUF;
                const LAS u16* QHs = (const LAS u16*)(buf + HG_OFF_QH); const LAS u16* KHT = (const LAS u16*)(buf + HG_OFF_KHT);
                const LAS u16* VTs = (const LAS u16*)(buf + HG_OFF_VT); const LAS u16* AP = (const LAS u16*)(buf + HG_OFF_AP); const LAS float* DEC = (const LAS float*)(buf + HG_OFF_DEC);
                bf16x8 vf[2], ka[4][2];
#pragma unroll
                for (int s2 = 0; s2 < 2; ++s2) vf[s2] = *(const LAS bf16x8*)(VTs + (32 * n + r) * HG_LD + 16 * s2 + 8 * h);
                if (cs >= 8) {
                    bf16x8 qa[4][2], apf[4][2], sp[4][2];
#pragma unroll
                    for (int kt = 0; kt < 4; ++kt)
#pragma unroll
                        for (int s2 = 0; s2 < 2; ++s2) {
                            const LAS u16* qp = QHs + r * HG_QH_LD + 32 * kt + 16 * s2 + 4 * h;
                            const u32x2 lo = *(const LAS u32x2*)qp, hi = *(const LAS u32x2*)(qp + 8);
                            const u32x4 q4v = {lo.x, lo.y, hi.x, hi.y};
                            qa[kt][s2] = __builtin_bit_cast(bf16x8, q4v);
                            apf[kt][s2] = *(const LAS bf16x8*)(AP + (kt * 32 + r) * HG_LD + 16 * s2 + 8 * h);
                        }
#pragma unroll
                    for (int kt = 0; kt < 4; ++kt)
#pragma unroll
                        for (int s2 = 0; s2 < 2; ++s2) {
                            u32x4 spk; spk.x = pk2(S[kt][8 * s2 + 0], S[kt][8 * s2 + 1]); spk.y = pk2(S[kt][8 * s2 + 2], S[kt][8 * s2 + 3]);
                            spk.z = pk2(S[kt][8 * s2 + 4], S[kt][8 * s2 + 5]); spk.w = pk2(S[kt][8 * s2 + 6], S[kt][8 * s2 + 7]);
                            sp[kt][s2] = __builtin_bit_cast(bf16x8, spk);
                        }
                    f32x16 o1, o2;
#pragma unroll
                    for (int i = 0; i < 16; ++i) { o1[i] = 0.f; o2[i] = 0.f; }
#pragma unroll
                    for (int kt = 0; kt < 4; ++kt)
#pragma unroll
                        for (int s2 = 0; s2 < 2; ++s2) { o1 = MFMA32(qa[kt][s2], sp[kt][s2], o1); o2 = MFMA32(apf[kt][s2], vf[s2], o2); }
#pragma unroll
                    for (int kt = 0; kt < 4; ++kt)
#pragma unroll
                        for (int s2 = 0; s2 < 2; ++s2) ka[kt][s2] = *(const LAS bf16x8*)(KHT + (32 * kt + r) * HG_LD + 16 * s2 + 8 * h);
#pragma unroll
                    for (int kt = 0; kt < 4; ++kt) {
#pragma unroll
                        for (int q4 = 0; q4 < 4; ++q4) { const f32x4 d4 = *(const LAS f32x4*)(DEC + 32 * kt + 8 * q4 + 4 * h);
                            S[kt][4 * q4 + 0] *= d4.x; S[kt][4 * q4 + 1] *= d4.y; S[kt][4 * q4 + 2] *= d4.z; S[kt][4 * q4 + 3] *= d4.w; }
#pragma unroll
                        for (int s2 = 0; s2 < 2; ++s2) S[kt] = MFMA32(ka[kt][s2], vf[s2], S[kt]);
                    }
                    const int cc = cs - 8;
                    if (dir) {
                        u16* ob = OUTg + ((size_t)(b * T + (T - 1 - 32 * cc - 4 * h))) * D + hh * 128 + 32 * n + r;
#pragma unroll
                        for (int i = 0; i < 16; ++i) ob[-(ptrdiff_t)(((i & 3) + 8 * (i >> 2)) * D)] = (u16)(pkh2(o1[i] + o2[i], 0.f) & 0xffffu);
                    } else {
                        u16* of = OUTg + ((size_t)(b * T + 32 * cc + 4 * h)) * D + hh * 128 + 32 * n + r;
#pragma unroll
                        for (int i = 0; i < 16; ++i) of[(size_t)(((i & 3) + 8 * (i >> 2)) * D)] = (u16)(pkh2(o1[i] + o2[i], 0.f) & 0xffffu);
                    }
                } else {
#pragma unroll
                    for (int kt = 0; kt < 4; ++kt)
#pragma unroll
                        for (int s2 = 0; s2 < 2; ++s2) ka[kt][s2] = *(const LAS bf16x8*)(KHT + (32 * kt + r) * HG_LD + 16 * s2 + 8 * h);
#pragma unroll
                    for (int kt = 0; kt < 4; ++kt) {
#pragma unroll
                        for (int q4 = 0; q4 < 4; ++q4) { const f32x4 d4 = *(const LAS f32x4*)(DEC + 32 * kt + 8 * q4 + 4 * h);
                            S[kt][4 * q4 + 0] *= d4.x; S[kt][4 * q4 + 1] *= d4.y; S[kt][4 * q4 + 2] *= d4.z; S[kt][4 * q4 + 3] *= d4.w; }
#pragma unroll
                        for (int s2 = 0; s2 < 2; ++s2) S[kt] = MFMA32(ka[kt][s2], vf[s2], S[kt]);
                    }
                }
            }
            BAR_LDS();
        }
    }
}

__device__ __forceinline__ void phase3b(const Params& p, int gw, int NGW, int lane) {
    const u16* OFh = (const u16*)(p.ws + WS_LFF); const u16* OBh = (const u16*)(p.ws + WS_LFB); u16* OB = (u16*)(p.ws + WS_OB);
    for (int row = gw; row < M; row += NGW) {
#pragma unroll
        for (int j = 0; j < 4; ++j) {
            const int c = 512 * j + 8 * lane; const size_t idx = (size_t)row * D + c;
            const u32x4 aa = *(const u32x4*)(OFh + idx); const u32x4 bb = *(const u32x4*)(OBh + idx);
            float v[8];
#pragma unroll
            for (int e = 0; e < 4; ++e) { const unsigned ua = aa[e], ub = bb[e];
                v[2 * e] = h2f((u16)(ua & 0xffffu)) + h2f((u16)(ub & 0xffffu)); v[2 * e + 1] = h2f((u16)(ua >> 16)) + h2f((u16)(ub >> 16)); }
            float ss = 0.f;
#pragma unroll
            for (int e = 0; e < 8; ++e) ss += v[e] * v[e];
            ss += __shfl_xor(ss, 1); ss += __shfl_xor(ss, 2); ss += __shfl_xor(ss, 4); ss += __shfl_xor(ss, 8);
            const float rstd = __builtin_amdgcn_rsqf(ss * (1.f / 128.f) + EPS);
            const f32x4 g0 = *(const f32x4*)(p.hg_gain + c), g1 = *(const f32x4*)(p.hg_gain + c + 4);
            v[0] *= rstd * g0.x; v[1] *= rstd * g0.y; v[2] *= rstd * g0.z; v[3] *= rstd * g0.w; v[4] *= rstd * g1.x; v[5] *= rstd * g1.y; v[6] *= rstd * g1.z; v[7] *= rstd * g1.w;
            *(u32x4*)(OB + idx) = pack8(v);
        }
    }
}

__device__ __forceinline__ void phase7(const Params& p, int gw, int NGW, int lane) {
    const float* rss = (const float*)(p.ws + WS_RSS);
    f32x4 g[8];
#pragma unroll
    for (int j = 0; j < 8; ++j) g[j] = *((const f32x4*)p.fgain + lane + 64 * j);
    for (int row = gw; row < M; row += 2 * NGW) {
        const int row2 = row + NGW; const bool has2 = row2 < M;
        f32x4* o1 = (f32x4*)(p.out + (size_t)row * D) + lane; f32x4* o2 = (f32x4*)(p.out + (size_t)(has2 ? row2 : row) * D) + lane;
        f32x4 v1[8], v2[8];
#pragma unroll
        for (int j = 0; j < 8; ++j) { v1[j] = o1[64 * j]; v2[j] = o2[64 * j]; }
        const float r1 = __builtin_amdgcn_rsqf(rss[row] * (1.f / D) + EPS), r2 = __builtin_amdgcn_rsqf(rss[has2 ? row2 : row] * (1.f / D) + EPS);
#pragma unroll
        for (int j = 0; j < 8; ++j) o1[64 * j] = v1[j] * r1 * g[j];
        if (has2) {
#pragma unroll
            for (int j = 0; j < 8; ++j) o2[64 * j] = v2[j] * r2 * g[j];
        }
    }
}

#define XB_TMO      128
#define XB_XCNT(j)  (256  + 64 * (j))
#define XB_XSUB(j)  (1280 + 64 * (j))
#define XB_XGEN(j)  (2304 + 64 * (j))
#define XB_TOP      3328
#define XB_TOPGEN   3392
#define XCD_BAR_WORDS 3456
#define XB_SPIN_CAP (1u << 18)
__device__ __forceinline__ unsigned xb_ld(unsigned* p)              { return __hip_atomic_load(p, __ATOMIC_RELAXED, __HIP_MEMORY_SCOPE_AGENT); }
__device__ __forceinline__ unsigned xb_add(unsigned* p, unsigned v) { return __hip_atomic_fetch_add(p, v, __ATOMIC_RELAXED, __HIP_MEMORY_SCOPE_AGENT); }
__device__ __forceinline__ unsigned xb_xcc_id() { return (unsigned)__builtin_amdgcn_s_getreg((3 << 11) | 20) & 0xFu; }
#define XB_SPIN(cond, bar) do { unsigned _sp = 0; while (cond) { __builtin_amdgcn_s_sleep(1); \
    if ((++_sp & 255u) == 0u) { if (xb_ld(&(bar)[XB_TMO])) break; if (_sp > XB_SPIN_CAP) { atomicAdd(&(bar)[XB_TMO], 1u); break; } } } } while (0)
struct XcdBarrier { unsigned* bar; unsigned x; volatile LAS unsigned* st; };
__device__ __forceinline__ XcdBarrier xcd_barrier_post(unsigned* bar, volatile LAS unsigned* st) {
    XcdBarrier b; b.bar = bar; b.x = xb_xcc_id(); b.st = st;
    if (threadIdx.x == 0) (void)xb_add(&bar[XB_XCNT(b.x)], 1u);
    return b;
}
__device__ __forceinline__ void xcd_barrier_complete(unsigned* bar, unsigned x, unsigned& nloc, unsigned& nx) {
    const unsigned G = gridDim.x * gridDim.y * gridDim.z;
    unsigned sum, cnt, mine, sp = 0u;
    for (;;) {
        sum = 0u; cnt = 0u; mine = 0u;
#pragma unroll
        for (unsigned j = 0; j < 16; ++j) { const unsigned c = xb_ld(&bar[XB_XCNT(j)]); sum += c; cnt += (c > 0u) ? 1u : 0u; mine = (j == x) ? c : mine; }
        if (sum == G) break;
        __builtin_amdgcn_s_sleep(1);
        if ((++sp & 255u) == 0u) { if (xb_ld(&bar[XB_TMO])) break; if (sp > XB_SPIN_CAP) { atomicAdd(&bar[XB_TMO], 1u); break; } }
    }
    nloc = mine > 0u ? mine : 1u; nx = cnt > 0u ? cnt : 1u;
}
__device__ __forceinline__ void xcd_barrier(const XcdBarrier& b) {
    asm volatile("s_waitcnt vmcnt(0)" ::: "memory");
    __syncthreads();
    if (threadIdx.x == 0) {
        unsigned* bar = b.bar;
        __builtin_amdgcn_s_waitcnt(0);
        unsigned nloc = b.st[0], nx = b.st[1];
        if (nloc == 0u) { xcd_barrier_complete(bar, b.x, nloc, nx); b.st[0] = nloc; b.st[1] = nx; }
        const unsigned old = xb_add(&bar[XB_XSUB(b.x)], 1u);
        const unsigned gen = old / nloc;
        if (old + 1u == (gen + 1u) * nloc) {
            __builtin_amdgcn_fence(__ATOMIC_RELEASE, "agent");
            asm volatile("s_waitcnt vmcnt(0)" ::: "memory");
            const unsigned og = xb_add(&bar[XB_TOP], 1u);
            const unsigned tg = og / nx;
            if (og + 1u == (tg + 1u) * nx) xb_add(&bar[XB_TOPGEN], 1u);
            else XB_SPIN(xb_ld(&bar[XB_TOPGEN]) == tg, bar);
            __builtin_amdgcn_fence(__ATOMIC_ACQUIRE, "agent");
            xb_add(&bar[XB_XGEN(b.x)], 1u);
            asm volatile("s_waitcnt vmcnt(0)" ::: "memory");
        } else {
            XB_SPIN(xb_ld(&bar[XB_XGEN(b.x)]) == gen, bar);
            __builtin_amdgcn_fence(__ATOMIC_ACQUIRE, "agent");
            asm volatile("s_waitcnt vmcnt(0)" ::: "memory");
        }
    }
    __syncthreads();
}

__global__ void __launch_bounds__(NTHREADS, 2) mega(Params p) {
    extern __shared__ __attribute__((aligned(16))) unsigned char lds_raw[];
    LAS unsigned char* lds = (LAS unsigned char*)lds_raw;
    cg::grid_group grid = cg::this_grid();
    const int tid = threadIdx.x, lane = tid & 63, wave = __builtin_amdgcn_readfirstlane(tid >> 6);
    const int G = gridDim.x, bid = blockIdx.x;
    const int gw = bid * 8 + wave, NGW = G * 8;
    const int lo = p.ph_lo, hi = p.ph_hi;
#define IN(k) (lo <= (k) && (k) < hi)
#define SEAM(k) do { if (IN(k) && IN((k) + 1)) xcd_barrier(xbar); } while (0)
    for (int i = tid; i < (LDS_BYTES - LDS_CTL) / 4; i += NTHREADS) ((LAS unsigned*)(lds + LDS_CTL))[i] = 0u;
    __syncthreads();
    const XcdBarrier xbar = xcd_barrier_post((unsigned*)(p.ws + WS_BAR), (volatile LAS unsigned*)(lds + LDS_CTL + 64));
    if (lo < 0) grid.sync();
    phase0_mod(p, gw, NGW, lane);
    SEAM(0);
    phase0_tr(p, lds, gw, NGW, wave, lane);
    phase1(p, gw, NGW, lane);
    SEAM(1);
    if (IN(2)) {
        pg8::Gemm g{(const u16*)(p.ws + WS_XN), (const u16*)(p.ws + WS_WINT), MTOT, N1, D};
        pg8::Order1 S{G, bid};
        EpiIn E{p.ws, p.lb_f, p.lb_b, p.b_merge, (u16*)p.out};
        pg8::gemm_phase<EpiIn, pg8::Order1>(lds, g, S, E);
    }
    SEAM(2);
    if (IN(3)) {
        if (bid < 128) { for (int u = bid; u < 128; u += (G < 128 ? G : 128)) hgrn_unit(p, lds, u, tid); }
        unsigned* qctr = (unsigned*)(p.ws + WS_QCTR);
        LAS int* sh = (LAS int*)(lds + LDS_CTL);
        int nxtq = 0;
        if (tid == 0) nxtq = (int)atomicAdd(qctr, 1u);
        for (;;) {
            if (tid == 0) sh[0] = nxtq;
            __syncthreads();
            const int pr = sh[0];
            __syncthreads();
            if (pr >= 880 + 1024) break;
            if (tid == 0) nxtq = (int)atomicAdd(qctr, 1u);
            if (pr >= 880) attn_unit(p, lds, pr - 880, tid);
            else {
                pg8::Gemm g{(const u16*)(p.ws + WS_XN), (const u16*)(p.ws + WS_WINT), MTOT, NCOL, D};
                pg8::OrderSingle S{144 + pr};
                EpiIn E{p.ws, p.lb_f, p.lb_b, p.b_merge, (u16*)p.out};
                pg8::gemm_phase<EpiIn, pg8::OrderSingle>(lds, g, S, E);
            }
        }
    }
    SEAM(3);
    if (IN(5)) {
        pg8::Gemm g{(const u16*)(p.ws + WS_XN), (const u16*)(p.ws + WS_WINT) + (size_t)N1 * D, M, 4096, D};
        pg8::StaticOrder S; S.init(M, 4096, G, bid);
        EpiGate E{p.ws, p.hg_gain, lds};
        pg8::gemm_phase<EpiGate, pg8::StaticOrder>(lds, g, S, E);
    }
    SEAM(5);
    if (IN(6)) {
        pg8::StaticOrder S; S.init(M, D, G, bid);
        { pg8::Gemm g{(const u16*)(p.ws + WS_OB), (const u16*)(p.ws + WS_WH), M, D, D}; EpiMerge<0> E{p.ws, (float*)(p.ws + WS_LFF), (const u16*)p.out}; pg8::gemm_phase<EpiMerge<0>, pg8::StaticOrder>(lds, g, S, E); }
        { pg8::Gemm g{(const u16*)(p.ws + WS_Q), (const u16*)(p.ws + WS_WA), M, D, D}; EpiMerge<1> E{p.ws, (float*)(p.ws + WS_LFF), (const u16*)p.out}; pg8::gemm_phase<EpiMerge<1>, pg8::StaticOrder>(lds, g, S, E); }
    }
    SEAM(6);
    if (IN(7)) {
        pg8::StaticOrder S; S.init(M, D, G, bid);
        pg8::Gemm g{(const u16*)(p.ws + WS_QH), (const u16*)(p.ws + WS_WO), M, D, D};
        EpiOut E{p.x, (const float*)(p.ws + WS_MOD), p.b_ada, p.out, (float*)(p.ws + WS_RSS)};
        pg8::gemm_phase<EpiOut, pg8::StaticOrder>(lds, g, S, E);
    }
    SEAM(7);
    if (IN(8)) phase7(p, gw, NGW, lane);
}

#ifndef N_LAUNCH_SPLIT
#define N_LAUNCH_SPLIT 0
#endif
extern "C" void kernel_launch(void* const* d_in, const int* in_sizes, int n_in, void* d_out, int out_size, void* d_ws, size_t ws_size, hipStream_t stream) {
    static int grid = 0;
    if (!grid) {
        int dev = 0, cus = 0, per_cu = 0;
        hipGetDevice(&dev);
        hipDeviceGetAttribute(&cus, hipDeviceAttributeMultiprocessorCount, dev);
        hipFuncSetAttribute((const void*)mega, hipFuncAttributeMaxDynamicSharedMemorySize, LDS_BYTES);
        hipOccupancyMaxActiveBlocksPerMultiprocessor(&per_cu, (const void*)mega, NTHREADS, LDS_BYTES);
        if (per_cu < 1) per_cu = 1;
        grid = cus * 1;
        if (ws_size < WS_END) { fprintf(stderr, "workspace too small: %zu < %zu\n", ws_size, (size_t)WS_END); grid = -1; }
    }
    if (grid <= 0) return;
    Params p{};
    p.x = (const float*)d_in[0]; p.c = (const float*)d_in[1]; p.ctx = (const float*)d_in[2]; p.c_ctx = (const float*)d_in[3];
    p.w_ada = (const float*)d_in[4]; p.b_ada = (const float*)d_in[5]; p.norm_gain = (const float*)d_in[6]; p.w_in = (const float*)d_in[7];
    p.b_merge = (const float*)d_in[8]; p.lb_f = (const float*)d_in[9]; p.lb_b = (const float*)d_in[10]; p.hg_gain = (const float*)d_in[11];
    p.w_o_hgrn = (const float*)d_in[12]; p.sink = (const float*)d_in[13]; p.w_o_attn = (const float*)d_in[14]; p.w_out = (const float*)d_in[15];
    p.fgain = (const float*)d_in[16];
    p.out = (float*)d_out; p.ws = (unsigned char*)d_ws;
    hipMemsetAsync(d_ws, 0, CTL_ZERO, stream);
#if N_LAUNCH_SPLIT
    for (int ph = 0; ph < 9; ++ph) { p.ph_lo = ph; p.ph_hi = ph + 1; hipLaunchKernelGGL(mega, dim3(grid), dim3(NTHREADS), LDS_BYTES, stream, p); }
#else
    p.ph_lo = 0; p.ph_hi = 9;
    void* args[] = {&p};
    hipError_t e = hipLaunchCooperativeKernel((const void*)mega, dim3(grid), dim3(NTHREADS), args, LDS_BYTES, stream);
    if (e != hipSuccess) fprintf(stderr, "cooperative launch failed: %s (grid %d)\n", hipGetErrorString(e), grid);
#endif
}
```

```cpp
#include <hip/hip_runtime.h>
#include <hip/hip_cooperative_groups.h>
#include <cstdio>
#include <cstdint>
namespace cg = cooperative_groups;

#define LAS __attribute__((address_space(3)))
typedef unsigned short u16;
typedef short bf16x8 __attribute__((ext_vector_type(8)));
typedef short s16x4 __attribute__((ext_vector_type(4)));
typedef float f32x2 __attribute__((ext_vector_type(2)));
typedef float f32x4 __attribute__((ext_vector_type(4)));
typedef float f32x16 __attribute__((ext_vector_type(16)));
typedef unsigned u32x2 __attribute__((ext_vector_type(2)));
typedef unsigned u32x4 __attribute__((ext_vector_type(4)));
typedef __bf16 bf2_t __attribute__((ext_vector_type(2)));
typedef _Float16 h2_t __attribute__((ext_vector_type(2)));

constexpr int D = 2048, NB = 4, T = 4096, M = NB * T, LC = 256, MC = NB * LC, MTOT = M + MC;
constexpr int NCOL = 19456, N1 = 11264, N2 = 8192;
constexpr int NMOD = 3 * D;
constexpr float EPS = 1e-6f;
constexpr float LOG2E = 1.4426950408889634f;
constexpr int NTHREADS = 512;
constexpr int LDS_BYTES = 131072 + 4096;
constexpr int LDS_SSB = 131072 + 1024;
constexpr int LDS_CTL = 131072;

constexpr size_t MiB = 1u << 20;
constexpr size_t WS_MOD = 0;
constexpr size_t WS_RSS = 131072;
constexpr size_t WS_QCTR = 200704;
constexpr size_t WS_BAR = 204800;
constexpr size_t CTL_ZERO = 262144;
constexpr size_t WS_WINT = 1 * MiB;
constexpr size_t WS_WH = 77 * MiB, WS_WA = 85 * MiB, WS_WO = 93 * MiB;
constexpr size_t WS_XN = 101 * MiB;
constexpr size_t WS_Q = 169 * MiB;
constexpr size_t WS_K = 233 * MiB;
constexpr size_t WS_VT = 249 * MiB;
constexpr size_t WS_QH = 265 * MiB;
constexpr size_t WS_LFF = 329 * MiB;
constexpr size_t WS_LFB = 393 * MiB;
constexpr size_t WS_VH = 457 * MiB;
constexpr size_t WS_KC = 521 * MiB;
constexpr size_t WS_VCT = 522 * MiB;
constexpr size_t WS_CFF = 523 * MiB, WS_CFB = 527 * MiB, WS_CI = 531 * MiB;
constexpr size_t WS_OB = 535 * MiB;
constexpr size_t WS_END = 599 * MiB;

__device__ __forceinline__ unsigned pk2(float a, float b) { f32x2 v = {a, b}; bf2_t r = __builtin_convertvector(v, bf2_t); return __builtin_bit_cast(unsigned, r); }
__device__ __forceinline__ unsigned pkh2(float a, float b) { f32x2 v = {a, b}; h2_t r = __builtin_convertvector(v, h2_t); return __builtin_bit_cast(unsigned, r); }
__device__ __forceinline__ float bf2f(u16 v) { return __uint_as_float(((unsigned)v) << 16); }
__device__ __forceinline__ float h2f(u16 v) { return (float)__builtin_bit_cast(_Float16, v); }
__device__ __forceinline__ float bflo(unsigned v) { return __uint_as_float(v << 16); }
__device__ __forceinline__ float bfhi(unsigned v) { return __uint_as_float(v & 0xffff0000u); }
__device__ __forceinline__ float fexp2(float x) { return __builtin_amdgcn_exp2f(x); }
__device__ __forceinline__ float sigmoidf_(float x) { return __builtin_amdgcn_rcpf(1.f + fexp2(-x * LOG2E)); }
__device__ __forceinline__ float siluf_(float x) { return x * sigmoidf_(x); }
#define LDS_WAIT() asm volatile("s_waitcnt lgkmcnt(0)" ::: "memory")
#define BAR_LDS() do { asm volatile("s_waitcnt lgkmcnt(0)" ::: "memory"); __builtin_amdgcn_s_barrier(); asm volatile("" ::: "memory"); } while (0)
#define MFMA32(a, b, c) __builtin_amdgcn_mfma_f32_32x32x16_bf16((a), (b), (c), 0, 0, 0)
__device__ __forceinline__ int crow(int reg, int h) { return (reg & 3) + 8 * (reg >> 2) + 4 * h; }

namespace pg8 {
typedef unsigned short bf16_t;
constexpr int BM = 256, BK = 64, HALF = 128, HTB = HALF * BK * 2, STAGE_BYTES = 8 * HTB, NXCD = 8, WGM = 8;
__host__ __device__ __forceinline__ int lds_byte(int r, int c) { const int st = (r >> 4) * 2 + (c >> 5), rr = r & 15, cc = c & 31, ob = rr * 64 + cc * 2; return st * 1024 + (ob ^ (((ob >> 9) & 1) << 5)); }
__host__ __device__ __forceinline__ void stage_rc(int b, int& R, int& C) { const int st = b / 1024, sb = b % 1024, swz = sb ^ (((sb >> 9) & 1) << 5); R = (st >> 1) * 16 + swz / 64; C = (st & 1) * 32 + (swz % 64) / 2; }
__host__ __device__ __forceinline__ int perm32(int rho) { const int n = rho >> 4, i = rho & 15; return 8 * (i >> 2) + 4 * n + (i & 3); }
struct Unit { int pm, pn; };
struct Gemm { const bf16_t* A; const bf16_t* Bt; int M, N, K; };
__device__ __forceinline__ void static_map(int L, int nM, int nN, Unit& u) {
    const int nwg = nM * nN; int wgid = L;
    { const int q = nwg / NXCD, r = nwg % NXCD, xcd = wgid % NXCD, off = wgid / NXCD; wgid = (xcd < r ? xcd * (q + 1) : r * (q + 1) + (xcd - r) * q) + off; }
    const int nig = WGM * nN, gid = wgid / nig, fm = gid * WGM, gsz = (nM - fm) < WGM ? (nM - fm) : WGM;
    u.pm = fm + ((wgid % nig) % gsz); u.pn = (wgid % nig) / gsz;
}
struct StaticOrder {
    int nM, nN, nwg, G, c;
    __device__ void init(int M_, int N_, int G_, int c_) { nM = M_ / BM; nN = N_ / BM; nwg = nM * nN; G = G_; c = c_; }
    __device__ bool next(int i, Unit& u) const { const long L = (long)i * G + c; if (L >= nwg) return false; static_map((int)L, nM, nN, u); return true; }
};
struct Order1 {
    int G, c;
    __device__ bool next(int i, Unit& u) const {
        const long L = (long)i * G + c;
        if (L < 64 * 44) { static_map((int)L, 64, 44, u); return true; }
        if (L < 64 * 44 + 112) { const int idx = (int)L - 64 * 44; u.pm = 64 + (idx & 3); u.pn = idx >> 2; return true; }
        if (L < 64 * 44 + 112 + 144) { static_map((int)L - (64 * 44 + 112), 64, 16, u); u.pn += 60; return true; }
        return false;
    }
};
struct OrderSingle {
    int q;
    __device__ bool next(int i, Unit& u) const { if (i > 0) return false; static_map(q, 64, 16, u); u.pn += 60; return true; }
};

template <class Epi, class Sched, bool ALIGN_EPI = true, bool SP2 = true>
__device__ __forceinline__ void gemm_phase(LAS unsigned char* lds, const Gemm g, const Sched& S, const Epi& E) {
    const int tid = threadIdx.x, wid = __builtin_amdgcn_readfirstlane(tid >> 6), lane = tid & 63, wr = wid >> 2, wc = wid & 3, fr = lane & 15, fq = lane >> 4;
    const int K = g.K, nt = K / BK;
    unsigned voffA[2], voffB[2];
#pragma unroll
    for (int i = 0; i < 2; ++i) { int R, C; stage_rc(tid * 16 + i * 8192, R, C); const int Rb = (R & ~31) + perm32(R & 31);
        voffA[i] = (unsigned)(R * K + C) * 2u; voffB[i] = (unsigned)(Rb * K + C) * 2u; }
    const size_t kstep = (size_t)(BK * 2);
    const int k0r = (int)(((unsigned)__builtin_amdgcn_s_getreg((3 << 11) | 20) & 7u) * (unsigned)(nt >> 3));
#define PG8_KO(t) ((size_t)(((t) + k0r) & (nt - 1)) * kstep)
    const size_t hstep = (size_t)HALF * K * 2;
    const size_t tstep = 2 * hstep;
    const unsigned ldsw = (unsigned)wid * 1024u;
    const int aoff = lds_byte(wr * 64 + fr, fq * 8), boff = lds_byte(wc * 32 + fr, fq * 8);
#define PG8_SA(b, h) (((b) * 2 + (h)) * HTB)
#define PG8_SB(b, h) ((4 + (b) * 2 + (h)) * HTB)
#define PG8_STAGE(bufoff, gbase, voff) do { _Pragma("unroll") for (int _i = 0; _i < 2; ++_i) \
        __builtin_amdgcn_global_load_lds((const unsigned*)((const char*)(gbase) + (voff)[_i]), (LAS unsigned*)(lds + (bufoff) + ldsw + _i * 8192), 16, 0, 0); } while (0)
#define PG8_LDA(dst, b, h) do { _Pragma("unroll") for (int m = 0; m < 4; ++m) _Pragma("unroll") for (int k = 0; k < 2; ++k) dst[m][k] = *(const LAS bf16x8*)(lds + PG8_SA(b, h) + aoff + m * 2048 + k * 1024); } while (0)
#define PG8_LDB(dst, b, h) do { _Pragma("unroll") for (int n = 0; n < 2; ++n) _Pragma("unroll") for (int k = 0; k < 2; ++k) dst[n][k] = *(const LAS bf16x8*)(lds + PG8_SB(b, h) + boff + n * 2048 + k * 1024); } while (0)
#define PG8_MMA(ai, bj, At, Bt) do { __builtin_amdgcn_s_setprio(1); _Pragma("unroll") for (int m = 0; m < 4; ++m) _Pragma("unroll") for (int n = 0; n < 2; ++n) _Pragma("unroll") for (int k = 0; k < 2; ++k) \
        acc[ai][bj][m][n] = __builtin_amdgcn_mfma_f32_16x16x32_bf16(Bt[n][k], At[m][k], acc[ai][bj][m][n], 0, 0, 0); __builtin_amdgcn_s_setprio(0); } while (0)
#define PG8_WAIT_V(n) asm volatile("s_waitcnt vmcnt(" #n ")" ::: "memory")
#define PG8_WAIT_L(n) asm volatile("s_waitcnt lgkmcnt(" #n ")" ::: "memory")
#define PG8_BAR __builtin_amdgcn_s_barrier()
#define PG8_SCHED __builtin_amdgcn_sched_barrier(0)
    Unit cur, nxt; int ui = 0;
    if (!S.next(0, cur)) return;
    f32x4 acc[2][2][4][2];
#pragma unroll
    for (int a = 0; a < 2; ++a)
#pragma unroll
        for (int b = 0; b < 2; ++b)
#pragma unroll
            for (int m = 0; m < 4; ++m)
#pragma unroll
                for (int n = 0; n < 2; ++n) acc[a][b][m][n] = (f32x4){0.f, 0.f, 0.f, 0.f};
    bf16x8 At[4][2], B0[2][2], B1[2][2];
    const char* cA = (const char*)g.A + (size_t)cur.pm * tstep; const char* cB = (const char*)g.Bt + (size_t)cur.pn * tstep;
    if constexpr (SP2) {
        PG8_STAGE(PG8_SB(0, 0), cB + PG8_KO(0), voffB); PG8_STAGE(PG8_SB(0, 1), cB + hstep + PG8_KO(0), voffB); PG8_STAGE(PG8_SA(0, 0), cA + PG8_KO(0), voffA); PG8_STAGE(PG8_SA(0, 1), cA + hstep + PG8_KO(0), voffA);
        if (wr == 1) PG8_BAR;
        PG8_WAIT_V(2); PG8_BAR;
        PG8_STAGE(PG8_SB(1, 0), cB + PG8_KO(1), voffB); PG8_STAGE(PG8_SA(1, 0), cA + PG8_KO(1), voffA); PG8_STAGE(PG8_SB(1, 1), cB + hstep + PG8_KO(1), voffB);
        PG8_WAIT_V(6); PG8_BAR;
    } else {
        PG8_STAGE(PG8_SB(0, 0), cB + PG8_KO(0), voffB); PG8_STAGE(PG8_SA(0, 0), cA + PG8_KO(0), voffA); PG8_STAGE(PG8_SB(0, 1), cB + hstep + PG8_KO(0), voffB); PG8_STAGE(PG8_SA(0, 1), cA + hstep + PG8_KO(0), voffA);
        if (wr == 1) PG8_BAR;
        PG8_WAIT_V(4); PG8_BAR;
        PG8_STAGE(PG8_SB(1, 0), cB + PG8_KO(1), voffB); PG8_STAGE(PG8_SA(1, 0), cA + PG8_KO(1), voffA); PG8_STAGE(PG8_SB(1, 1), cB + hstep + PG8_KO(1), voffB);
        PG8_WAIT_V(6); PG8_BAR;
    }
    for (;;) {
        const bool has_next = S.next(ui + 1, nxt);
        const char* nA = has_next ? (const char*)g.A + (size_t)nxt.pm * tstep : cA; const char* nB = has_next ? (const char*)g.Bt + (size_t)nxt.pn * tstep : cB;
        for (int t = 0; t < nt; t += 2) {
            const bool last = (t == nt - 2);
            const char* a1 = cA + PG8_KO(t + 1);
            const char* a2 = (last ? nA : cA) + PG8_KO(t + 2); const char* b2 = (last ? nB : cB) + PG8_KO(t + 2);
            const char* a3 = (last ? nA : cA) + PG8_KO(t + 3); const char* b3 = (last ? nB : cB) + PG8_KO(t + 3);
            if constexpr (SP2) {
            PG8_LDB(B0, 0, 0); PG8_LDB(B1, 0, 1); PG8_SCHED; PG8_LDA(At, 0, 0); PG8_STAGE(PG8_SA(1, 1), a1 + hstep, voffA);
            PG8_WAIT_V(8); PG8_WAIT_L(0); PG8_BAR; PG8_MMA(0, 0, At, B0); PG8_MMA(0, 1, At, B1); PG8_BAR; PG8_SCHED;
            PG8_LDA(At, 0, 1); PG8_STAGE(PG8_SB(0, 0), b2, voffB); PG8_STAGE(PG8_SB(0, 1), b2 + hstep, voffB); PG8_STAGE(PG8_SA(0, 0), a2, voffA);
            PG8_WAIT_V(8); PG8_WAIT_L(0); PG8_BAR; PG8_MMA(1, 0, At, B0); PG8_MMA(1, 1, At, B1); PG8_BAR; PG8_SCHED;
            PG8_LDB(B0, 1, 0); PG8_LDB(B1, 1, 1); PG8_SCHED; PG8_LDA(At, 1, 0); PG8_STAGE(PG8_SA(0, 1), a2 + hstep, voffA);
            PG8_WAIT_V(8); PG8_WAIT_L(0); PG8_BAR; PG8_MMA(0, 0, At, B0); PG8_MMA(0, 1, At, B1); PG8_BAR; PG8_SCHED;
            PG8_LDA(At, 1, 1); PG8_STAGE(PG8_SB(1, 0), b3, voffB); PG8_STAGE(PG8_SB(1, 1), b3 + hstep, voffB); PG8_STAGE(PG8_SA(1, 0), a3, voffA);
            PG8_WAIT_V(8); PG8_WAIT_L(0); PG8_BAR; PG8_MMA(1, 0, At, B0); PG8_MMA(1, 1, At, B1); PG8_BAR; PG8_SCHED;
            } else {
            PG8_LDB(B0, 0, 0); PG8_SCHED; PG8_LDA(At, 0, 0); PG8_STAGE(PG8_SA(1, 1), a1 + hstep, voffA);
            PG8_WAIT_L(8); PG8_BAR; PG8_WAIT_L(0); PG8_MMA(0, 0, At, B0); PG8_BAR; PG8_SCHED;
            PG8_LDB(B1, 0, 1); PG8_STAGE(PG8_SB(0, 0), b2, voffB);
            PG8_BAR; PG8_WAIT_L(0); PG8_MMA(0, 1, At, B1); PG8_BAR;
            PG8_LDA(At, 0, 1); PG8_STAGE(PG8_SA(0, 0), a2, voffA);
            PG8_BAR; PG8_WAIT_L(0); PG8_MMA(1, 0, At, B0); PG8_BAR; PG8_SCHED;
            PG8_STAGE(PG8_SB(0, 1), b2 + hstep, voffB);
            PG8_WAIT_V(6); PG8_BAR; PG8_MMA(1, 1, At, B1); PG8_BAR;
            PG8_LDB(B0, 1, 0); PG8_SCHED; PG8_LDA(At, 1, 0); PG8_STAGE(PG8_SA(0, 1), a2 + hstep, voffA);
            PG8_WAIT_L(8); PG8_BAR; PG8_WAIT_L(0); PG8_MMA(0, 0, At, B0); PG8_BAR; PG8_SCHED;
            PG8_LDB(B1, 1, 1); PG8_STAGE(PG8_SB(1, 0), b3, voffB);
            PG8_BAR; PG8_WAIT_L(0); PG8_MMA(0, 1, At, B1); PG8_BAR;
            PG8_LDA(At, 1, 1); PG8_STAGE(PG8_SA(1, 0), a3, voffA);
            PG8_BAR; PG8_WAIT_L(0); PG8_MMA(1, 0, At, B0); PG8_BAR; PG8_SCHED;
            PG8_STAGE(PG8_SB(1, 1), b3 + hstep, voffB);
            PG8_WAIT_V(6); PG8_BAR; PG8_MMA(1, 1, At, B1); PG8_BAR;
            }
        }
        if constexpr (ALIGN_EPI) { if (wr == 0) PG8_BAR; }
        E(acc, cur, wr, wc, fr, fq);
        if (!has_next) break;
#pragma unroll
        for (int a = 0; a < 2; ++a)
#pragma unroll
            for (int b = 0; b < 2; ++b)
#pragma unroll
                for (int m = 0; m < 4; ++m)
#pragma unroll
                    for (int n = 0; n < 2; ++n) acc[a][b][m][n] = (f32x4){0.f, 0.f, 0.f, 0.f};
        cur = nxt; cA = nA; cB = nB; ++ui;
        if constexpr (ALIGN_EPI) { if (wr == 1) PG8_BAR; }
    }
    PG8_WAIT_V(0);
    if constexpr (!ALIGN_EPI) { if (wr == 0) PG8_BAR; }
    PG8_BAR;
#undef PG8_KO
#undef PG8_SA
#undef PG8_SB
#undef PG8_STAGE
#undef PG8_LDA
#undef PG8_LDB
#undef PG8_MMA
#undef PG8_WAIT_V
#undef PG8_WAIT_L
#undef PG8_BAR
#undef PG8_SCHED
}
}
using pg8::Unit;
typedef f32x4 AccT[2][2][4][2];

struct Params {
    const float *x, *c, *ctx, *c_ctx, *w_ada, *b_ada, *norm_gain, *w_in, *b_merge, *lb_f, *lb_b, *hg_gain, *w_o_hgrn, *sink, *w_o_attn, *w_out, *fgain;
    float* out; unsigned char* ws;
    int ph_lo, ph_hi;
};

__device__ __forceinline__ int rope_inv(int d) { const int half = d >> 6, dd = d & 63, hi = dd >> 5, r = dd & 31; return ((half * 8 + (r >> 2)) * 8) + hi * 4 + (r & 3); }
__device__ __forceinline__ int dest_row(int c) {
    if (c < 2048) return 7168 + (c & ~127) + rope_inv(c & 127);
    if (c < 2560) { const int cc = c - 2048; return (cc & ~127) + rope_inv(cc & 127); }
    if (c < 3072) return 512 + (c - 2560);
    if (c < 5120) return 11264 + (c - 3072);
    if (c < 7168) return 9216 + (c - 5120);
    if (c < 9216) return 1024 + (c - 7168);
    if (c < 11264) return 3072 + (c - 9216);
    if (c < 13312) return 5120 + (c - 11264);
    return c;
}

__device__ __forceinline__ void transpose_item(const float* W, int K, int N, u16* WT, bool permute, LAS float* scr, int item, int lane) {
    const int nblk = N / 32, kb = item / nblk, nb = item % nblk, k0 = 64 * kb, n0 = 32 * nb;
    float tv[32];
#pragma unroll
    for (int i = 0; i < 32; ++i) { const int kk = 2 * i + (lane >> 5); tv[i] = W[(size_t)(k0 + kk) * N + n0 + (lane & 31)]; }
#pragma unroll
    for (int i = 0; i < 32; ++i) { const int kk = 2 * i + (lane >> 5); scr[kk * 33 + (lane & 31)] = tv[i]; }
    LDS_WAIT();
    const int c = lane & 7;
#pragma unroll
    for (int j = 0; j < 4; ++j) { const int n = (lane >> 3) + 8 * j; const LAS float* s = scr + (8 * c) * 33 + n;
        u32x4 o; o.x = pk2(s[0 * 33], s[1 * 33]); o.y = pk2(s[2 * 33], s[3 * 33]); o.z = pk2(s[4 * 33], s[5 * 33]); o.w = pk2(s[6 * 33], s[7 * 33]);
        const int row = permute ? dest_row(n0 + n) : (n0 + n);
        *(u32x4*)(WT + (size_t)row * K + k0 + 8 * c) = o; }
    LDS_WAIT();
}

__device__ __forceinline__ float wave_sum(float v) {
#pragma unroll
    for (int o = 1; o < 64; o <<= 1) v += __shfl_xor(v, o);
    return v;
}

__device__ __forceinline__ void phase0_mod(const Params& p, int gw, int NGW, int lane) {
    float* mod = (float*)(p.ws + WS_MOD);
    for (int it = gw; it < 64 * 96; it += NGW) {
        const int ks = it / 96, nc = it % 96, k0 = 32 * ks, n = 64 * nc + lane;
        float sv[5];
#pragma unroll
        for (int r = 0; r < 5; ++r) { const float cv = (r < 4) ? p.c[r * D + k0 + (lane & 31)] : p.c_ctx[k0 + (lane & 31)]; sv[r] = siluf_(cv); }
        float acc[5] = {0.f, 0.f, 0.f, 0.f, 0.f};
        const float* wp = p.w_ada + (size_t)k0 * NMOD + n;
#pragma unroll
        for (int kk = 0; kk < 32; ++kk) { const float w = wp[(size_t)kk * NMOD];
#pragma unroll
            for (int r = 0; r < 5; ++r) acc[r] += __shfl(sv[r], kk) * w; }
#pragma unroll
        for (int r = 0; r < 5; ++r) atomicAdd(mod + r * NMOD + n, acc[r]);
    }
}
__device__ __forceinline__ void phase0_tr(const Params& p, LAS unsigned char* lds, int gw, int NGW, int wave, int lane) {
    LAS float* scr = (LAS float*)(lds + wave * 16384);
    constexpr int I_IN = (D / 64) * (NCOL / 32), I_O = (D / 64) * (D / 32);
    for (int it = gw; it < I_IN + 3 * I_O; it += NGW) {
        int r = it;
        if (r < I_IN) { transpose_item(p.w_in, D, NCOL, (u16*)(p.ws + WS_WINT), true, scr, r, lane); continue; } r -= I_IN;
        if (r < I_O) { transpose_item(p.w_o_hgrn, D, D, (u16*)(p.ws + WS_WH), false, scr, r, lane); continue; } r -= I_O;
        if (r < I_O) { transpose_item(p.w_o_attn, D, D, (u16*)(p.ws + WS_WA), false, scr, r, lane); continue; } r -= I_O;
        transpose_item(p.w_out, D, D, (u16*)(p.ws + WS_WO), false, scr, r, lane);
    }
}

__device__ __forceinline__ void phase1(const Params& p, int gw, int NGW, int lane) {
    const float* mod = (const float*)(p.ws + WS_MOD);
    u16* XN = (u16*)(p.ws + WS_XN);
    for (int rowa = gw; rowa < MTOT; rowa += 2 * NGW) {
        const int rowb = (rowa + NGW < MTOT) ? rowa + NGW : rowa;
        const float* srca = (rowa < M) ? p.x + (size_t)rowa * D : p.ctx + (size_t)(rowa - M) * D;
        const float* srcb = (rowb < M) ? p.x + (size_t)rowb * D : p.ctx + (size_t)(rowb - M) * D;
        f32x4 va[8], vb[8]; float sa_ = 0.f, sb_ = 0.f;
#pragma unroll
        for (int j = 0; j < 8; ++j) { va[j] = ((const f32x4*)srca)[lane + 64 * j]; vb[j] = ((const f32x4*)srcb)[lane + 64 * j]; }
#pragma unroll
        for (int j = 0; j < 8; ++j) { sa_ += (va[j].x * va[j].x + va[j].y * va[j].y) + (va[j].z * va[j].z + va[j].w * va[j].w); sb_ += (vb[j].x * vb[j].x + vb[j].y * vb[j].y) + (vb[j].z * vb[j].z + vb[j].w * vb[j].w); }
        const float rsa = __builtin_amdgcn_rsqf(wave_sum(sa_) * (1.f / D) + EPS), rsb = __builtin_amdgcn_rsqf(wave_sum(sb_) * (1.f / D) + EPS);
        const int ra = (rowa < M) ? (rowa / T) : 4, rb = (rowb < M) ? (rowb / T) : 4;
#pragma unroll
        for (int j = 0; j < 8; ++j) {
            const int c = 4 * (lane + 64 * j);
            const f32x4 g = *(const f32x4*)(p.norm_gain + c);
            const f32x4 bsh = *(const f32x4*)(p.b_ada + c), bsc = *(const f32x4*)(p.b_ada + D + c);
            { const f32x4 sh = *(const f32x4*)(mod + ra * NMOD + c) + bsh; const f32x4 sc = *(const f32x4*)(mod + ra * NMOD + D + c) + bsc;
              const f32x4 y = (va[j] * rsa) * g * (sc + 1.f) + sh; u32x2 o; o.x = pk2(y.x, y.y); o.y = pk2(y.z, y.w); *(u32x2*)(XN + (size_t)rowa * D + c) = o; }
            if (rowb != rowa) { const f32x4 sh = *(const f32x4*)(mod + rb * NMOD + c) + bsh; const f32x4 sc = *(const f32x4*)(mod + rb * NMOD + D + c) + bsc;
              const f32x4 y = (vb[j] * rsb) * g * (sc + 1.f) + sh; u32x2 o; o.x = pk2(y.x, y.y); o.y = pk2(y.z, y.w); *(u32x2*)(XN + (size_t)rowb * D + c) = o; }
        }
    }
}

#define EPI_V8(acc, ai, bj, m, v) float v[8]; { const f32x4 _a = acc[ai][bj][m][0], _b = acc[ai][bj][m][1]; v[0] = _a.x; v[1] = _a.y; v[2] = _a.z; v[3] = _a.w; v[4] = _b.x; v[5] = _b.y; v[6] = _b.z; v[7] = _b.w; }
__device__ __forceinline__ u32x4 pack8(const float* v) { u32x4 o; o.x = pk2(v[0], v[1]); o.y = pk2(v[2], v[3]); o.z = pk2(v[4], v[5]); o.w = pk2(v[6], v[7]); return o; }
__device__ __forceinline__ u32x4 pack8h(const float* v) { u32x4 o; o.x = pkh2(v[0], v[1]); o.y = pkh2(v[2], v[3]); o.z = pkh2(v[4], v[5]); o.w = pkh2(v[6], v[7]); return o; }

struct EpiIn {
    unsigned char* ws; const float* lbf; const float* lbb; const float* bm; u16* sg;
    __device__ __forceinline__ void operator()(const AccT& acc, const Unit& u, int wr, int wc, int fr, int fq) const {
        const int pn = u.pn; const bool isctx = u.pm >= 64;
        const int row0 = u.pm * 256 + wr * 64 + fr;
        const int cw = 32 * wc + 8 * fq;
        if (pn >= 60) {
            const int grp = (pn - 60) >> 3; const int colbase = ((pn - 60) & 7) * 256;
            u16* base = sg + (size_t)grp * M * D;
#pragma unroll
            for (int ai = 0; ai < 2; ++ai)
#pragma unroll
                for (int m = 0; m < 4; ++m) {
                    const int row = row0 + 128 * ai + 16 * m;
#pragma unroll
                    for (int bj = 0; bj < 2; ++bj) {
                        EPI_V8(acc, ai, bj, m, v);
                        const int c = colbase + 128 * bj + cw;
                        const float* bp = bm + grp * D + c;
                        const f32x4 b0 = *(const f32x4*)bp, b1 = *(const f32x4*)(bp + 4);
                        v[0] = sigmoidf_(v[0] + b0.x); v[1] = sigmoidf_(v[1] + b0.y); v[2] = sigmoidf_(v[2] + b0.z); v[3] = sigmoidf_(v[3] + b0.w);
                        v[4] = sigmoidf_(v[4] + b1.x); v[5] = sigmoidf_(v[5] + b1.y); v[6] = sigmoidf_(v[6] + b1.z); v[7] = sigmoidf_(v[7] + b1.w);
                        *(u32x4*)(base + (size_t)row * D + c) = pack8(v);
                    }
                }
        } else if (pn < 2 || (pn >= 28 && pn < 36)) {
            const bool isq = pn >= 28;
            const int g = cw >> 3;
            const int axis = g >> 3; const int f0 = (g & 7) * 4;
            float invf[4];
#pragma unroll
            for (int e = 0; e < 4; ++e) invf[e] = fexp2(-(float)(f0 + e) * 0.41524101186092029f) * 0.15915494309189535f;
            const float qs = isq ? (0.08838834764831845f * LOG2E) : 1.f;
            u16* base; int ld, colbase;
            if (isq) { base = (u16*)(ws + WS_Q); ld = D; colbase = (pn - 28) * 256; }
            else if (!isctx) { base = (u16*)(ws + WS_K); ld = 512; colbase = pn * 256; }
            else { base = (u16*)(ws + WS_KC); ld = 512; colbase = pn * 256; }
#pragma unroll
            for (int ai = 0; ai < 2; ++ai)
#pragma unroll
                for (int m = 0; m < 4; ++m) {
                    const int row = row0 + 128 * ai + 16 * m;
                    const int orow = isctx ? row - M : row;
                    const int t = row & (T - 1);
                    const float pos = (float)(axis ? (t & 63) : (t >> 6));
                    float cs[4], sn[4];
#pragma unroll
                    for (int e = 0; e < 4; ++e) { const float rev = pos * invf[e]; cs[e] = isctx ? 1.f : __builtin_amdgcn_cosf(rev); sn[e] = isctx ? 0.f : __builtin_amdgcn_sinf(rev); }
#pragma unroll
                    for (int bj = 0; bj < 2; ++bj) {
                        EPI_V8(acc, ai, bj, m, v);
                        float o[8];
#pragma unroll
                        for (int e = 0; e < 4; ++e) { o[e] = (v[e] * cs[e] - v[4 + e] * sn[e]) * qs; o[4 + e] = (v[4 + e] * cs[e] + v[e] * sn[e]) * qs; }
                        *(u32x4*)(base + (size_t)orow * ld + colbase + 128 * bj + cw) = pack8(o);
                    }
                }
        } else if (pn < 4) {
#pragma unroll
            for (int ai = 0; ai < 2; ++ai)
#pragma unroll
                for (int m = 0; m < 4; ++m) {
                    const int row = row0 + 128 * ai + 16 * m;
#pragma unroll
                    for (int bj = 0; bj < 2; ++bj) {
                        EPI_V8(acc, ai, bj, m, v);
                        const int kvh = (pn - 2) * 2 + bj;
                        u16* dst;
                        if (!isctx) { const int b = row >> 12, t = row & (T - 1); dst = (u16*)(ws + WS_VT) + ((size_t)((b * 4 + kvh) * 128 + cw)) * T + t;
#pragma unroll
                            for (int e = 0; e < 8; ++e) dst[(size_t)e * T] = (u16)(pk2(v[e], 0.f) & 0xffffu);
                        } else { const int rr = row - M, b = rr >> 8, t = rr & (LC - 1); dst = (u16*)(ws + WS_VCT) + ((size_t)((b * 4 + kvh) * 128 + cw)) * LC + t;
#pragma unroll
                            for (int e = 0; e < 8; ++e) dst[(size_t)e * LC] = (u16)(pk2(v[e], 0.f) & 0xffffu);
                        }
                    }
                }
        } else if (pn < 20) {
            const bool bwd = pn >= 12;
            const float* lbl = bwd ? lbb : lbf;
            const int colbase = (pn - (bwd ? 12 : 4)) * 256;
            u16* base = (u16*)(ws + (isctx ? (bwd ? WS_CFB : WS_CFF) : (bwd ? WS_LFB : WS_LFF)));
            float lb[2][8];
#pragma unroll
            for (int bj = 0; bj < 2; ++bj)
#pragma unroll
                for (int e = 0; e < 8; ++e) { const int c = colbase + 128 * bj + cw + e; lb[bj][e] = __builtin_amdgcn_rcpf(1.f + fexp2((lbl[D + c] - lbl[c]) * LOG2E)); }
#pragma unroll
            for (int ai = 0; ai < 2; ++ai)
#pragma unroll
                for (int m = 0; m < 4; ++m) {
                    const int row = row0 + 128 * ai + 16 * m; const int orow = isctx ? row - M : row;
#pragma unroll
                    for (int bj = 0; bj < 2; ++bj) {
                        EPI_V8(acc, ai, bj, m, v);
                        float o[8];
#pragma unroll
                        for (int e = 0; e < 8; ++e) o[e] = (1.f - lb[bj][e]) * sigmoidf_(-v[e]);
                        *(u32x4*)(base + (size_t)orow * D + colbase + 128 * bj + cw) = pack8h(o);
                    }
                }
        } else {
            const bool ishq = pn >= 36;
            const int colbase = (pn - (ishq ? 36 : 20)) * 256;
            u16* base = (u16*)(ws + (ishq ? WS_QH : (isctx ? WS_CI : WS_VH)));
#pragma unroll
            for (int ai = 0; ai < 2; ++ai)
#pragma unroll
                for (int m = 0; m < 4; ++m) {
                    const int row = row0 + 128 * ai + 16 * m; const int orow = isctx ? row - M : row;
#pragma unroll
                    for (int bj = 0; bj < 2; ++bj) {
                        EPI_V8(acc, ai, bj, m, v);
                        if (ishq) {
#pragma unroll
                            for (int e = 0; e < 8; ++e) v[e] = siluf_(v[e]);
                        }
                        *(u32x4*)(base + (size_t)orow * D + colbase + 128 * bj + cw) = pack8(v);
                    }
                }
        }
    }
};

struct EpiGate {
    unsigned char* ws; const float* hgain; LAS unsigned char* lds;
    __device__ __forceinline__ void operator()(const AccT& acc, const Unit& u, int wr, int wc, int fr, int fq) const {
        const int grp = u.pn >> 3; const int colbase = (u.pn & 7) * 256;
        const int row0 = u.pm * 256 + wr * 64 + fr; const int cw = 32 * wc + 8 * fq;
        if (grp == 0) {
            u16* base = (u16*)(ws + WS_Q);
#pragma unroll
            for (int ai = 0; ai < 2; ++ai)
#pragma unroll
                for (int m = 0; m < 4; ++m) {
                    const int row = row0 + 128 * ai + 16 * m;
#pragma unroll
                    for (int bj = 0; bj < 2; ++bj) {
                        EPI_V8(acc, ai, bj, m, v);
                        u16* dst = base + (size_t)row * D + colbase + 128 * bj + cw;
                        const u32x4 in = *(const u32x4*)dst;
                        v[0] = siluf_(v[0]) * bflo(in.x); v[1] = siluf_(v[1]) * bfhi(in.x); v[2] = siluf_(v[2]) * bflo(in.y); v[3] = siluf_(v[3]) * bfhi(in.y);
                        v[4] = siluf_(v[4]) * bflo(in.z); v[5] = siluf_(v[5]) * bfhi(in.z); v[6] = siluf_(v[6]) * bflo(in.w); v[7] = siluf_(v[7]) * bfhi(in.w);
                        *(u32x4*)dst = pack8(v);
                    }
                }
        } else {
            const u16* OFh = (const u16*)(ws + WS_LFF); const u16* OBh = (const u16*)(ws + WS_LFB); u16* OB = (u16*)(ws + WS_OB);
            LAS float* ssb = (LAS float*)(lds + LDS_SSB);
#pragma unroll
            for (int ai = 0; ai < 2; ++ai) {
                unsigned xs[4][2][4];
#pragma unroll
                for (int m = 0; m < 4; ++m)
#pragma unroll
                    for (int bj = 0; bj < 2; ++bj) {
                        const size_t idx = (size_t)(row0 + 128 * ai + 16 * m) * D + colbase + 128 * bj + cw;
                        const u32x4 a = *(const u32x4*)(OFh + idx), b = *(const u32x4*)(OBh + idx);
                        float ss = 0.f;
#pragma unroll
                        for (int e = 0; e < 4; ++e) { const float x0 = h2f((u16)(a[e] & 0xffffu)) + h2f((u16)(b[e] & 0xffffu)), x1 = h2f((u16)(a[e] >> 16)) + h2f((u16)(b[e] >> 16)); ss += x0 * x0 + x1 * x1; xs[m][bj][e] = pkh2(x0, x1); }
                        ss += __shfl_xor(ss, 16); ss += __shfl_xor(ss, 32);
                        if (fq == 0) atomicAdd((float*)(ssb + (128 * ai + 64 * wr + 16 * m + fr) * 2 + bj), ss);
                    }
                BAR_LDS();
#pragma unroll
                for (int m = 0; m < 4; ++m)
#pragma unroll
                    for (int bj = 0; bj < 2; ++bj) {
                        EPI_V8(acc, ai, bj, m, v);
                        const size_t idx = (size_t)(row0 + 128 * ai + 16 * m) * D + colbase + 128 * bj + cw;
                        const float rstd = __builtin_amdgcn_rsqf(ssb[(128 * ai + 64 * wr + 16 * m + fr) * 2 + bj] * (1.f / 128.f) + EPS);
                        const float* gp = hgain + colbase + 128 * bj + cw; const f32x4 ga = *(const f32x4*)gp, gb = *(const f32x4*)(gp + 4);
                        const float g8[8] = {ga.x, ga.y, ga.z, ga.w, gb.x, gb.y, gb.z, gb.w};
#pragma unroll
                        for (int e = 0; e < 4; ++e) { const unsigned xp = xs[m][bj][e]; const float x0 = h2f((u16)(xp & 0xffffu)), x1 = h2f((u16)(xp >> 16));
                            v[2 * e] = siluf_(v[2 * e]) * (x0 * rstd * g8[2 * e]); v[2 * e + 1] = siluf_(v[2 * e + 1]) * (x1 * rstd * g8[2 * e + 1]); }
                        *(u32x4*)(OB + idx) = pack8(v);
                    }
                asm volatile("" ::: "memory");
            }
            BAR_LDS();
            if (fq == 0 && wc == 0) {
#pragma unroll
                for (int ai = 0; ai < 2; ++ai)
#pragma unroll
                    for (int m = 0; m < 4; ++m) { ssb[(128 * ai + 64 * wr + 16 * m + fr) * 2] = 0.f; ssb[(128 * ai + 64 * wr + 16 * m + fr) * 2 + 1] = 0.f; }
            }
        }
    }
};

template <int MODE> struct EpiMerge {
    unsigned char* ws; float* tmp; const u16* sgate;
    __device__ __forceinline__ void operator()(const AccT& acc, const Unit& u, int wr, int wc, int fr, int fq) const {
        const int colbase = u.pn * 256; const int row0 = u.pm * 256 + wr * 64 + fr; const int cw = 32 * wc + 8 * fq;
        const u16* sg = sgate + (size_t)MODE * M * D;
        u16* Y = (u16*)(ws + WS_QH);
#pragma unroll
        for (int ai = 0; ai < 2; ++ai)
#pragma unroll
            for (int m = 0; m < 4; ++m) {
                const int row = row0 + 128 * ai + 16 * m;
#pragma unroll
                for (int bj = 0; bj < 2; ++bj) {
                    EPI_V8(acc, ai, bj, m, v);
                    const size_t idx = (size_t)row * D + colbase + 128 * bj + cw;
                    const u32x4 s = *(const u32x4*)(sg + idx);
                    v[0] *= bflo(s.x); v[1] *= bfhi(s.x); v[2] *= bflo(s.y); v[3] *= bfhi(s.y); v[4] *= bflo(s.z); v[5] *= bfhi(s.z); v[6] *= bflo(s.w); v[7] *= bfhi(s.w);
                    if (MODE == 0) { *(f32x4*)(tmp + idx) = (f32x4){v[0], v[1], v[2], v[3]}; *(f32x4*)(tmp + idx + 4) = (f32x4){v[4], v[5], v[6], v[7]}; }
                    else { const f32x4 t0 = *(const f32x4*)(tmp + idx), t1 = *(const f32x4*)(tmp + idx + 4);
                        v[0] += t0.x; v[1] += t0.y; v[2] += t0.z; v[3] += t0.w; v[4] += t1.x; v[5] += t1.y; v[6] += t1.z; v[7] += t1.w;
                        *(u32x4*)(Y + idx) = pack8(v); }
                }
            }
    }
};

struct EpiOut {
    const float* x; const float* mod; const float* b_ada; float* out; float* rss;
    __device__ __forceinline__ void operator()(const AccT& acc, const Unit& u, int wr, int wc, int fr, int fq) const {
        const int colbase = u.pn * 256; const int row0 = u.pm * 256 + wr * 64 + fr; const int cw = 32 * wc + 8 * fq;
        const int b = u.pm >> 4;
        float gt[2][8];
#pragma unroll
        for (int bj = 0; bj < 2; ++bj)
#pragma unroll
            for (int e = 0; e < 8; ++e) { const int c = colbase + 128 * bj + cw + e; gt[bj][e] = mod[b * NMOD + 2 * D + c] + b_ada[2 * D + c]; }
#pragma unroll
        for (int ai = 0; ai < 2; ++ai)
#pragma unroll
            for (int m = 0; m < 4; ++m) {
                const int row = row0 + 128 * ai + 16 * m; float ss = 0.f;
#pragma unroll
                for (int bj = 0; bj < 2; ++bj) {
                    EPI_V8(acc, ai, bj, m, v);
                    const size_t idx = (size_t)row * D + colbase + 128 * bj + cw;
                    const f32x4 x0 = *(const f32x4*)(x + idx), x1 = *(const f32x4*)(x + idx + 4);
                    f32x4 h0, h1;
                    h0.x = x0.x + gt[bj][0] * v[0]; h0.y = x0.y + gt[bj][1] * v[1]; h0.z = x0.z + gt[bj][2] * v[2]; h0.w = x0.w + gt[bj][3] * v[3];
                    h1.x = x1.x + gt[bj][4] * v[4]; h1.y = x1.y + gt[bj][5] * v[5]; h1.z = x1.z + gt[bj][6] * v[6]; h1.w = x1.w + gt[bj][7] * v[7];
                    ss += (h0.x * h0.x + h0.y * h0.y) + (h0.z * h0.z + h0.w * h0.w) + (h1.x * h1.x + h1.y * h1.y) + (h1.z * h1.z + h1.w * h1.w);
                    *(f32x4*)(out + idx) = h0; *(f32x4*)(out + idx + 4) = h1;
                }
                ss += __shfl_xor(ss, 16); ss += __shfl_xor(ss, 32);
                if (fq == 0) atomicAdd(rss + row, ss);
            }
    }
};

constexpr int AK_LD = 136, AV_LD = 72;
constexpr int ATT_BUF = (64 * AK_LD + 128 * AV_LD) * 2;
__device__ __forceinline__ void attn_unit(const Params& p, LAS unsigned char* lds, int unit, int tid) {
    const int hp = unit & 1, kvh = (unit >> 1) & 3, qb = (unit >> 3) & 31, b = unit >> 8;
    const int wave = tid >> 6, lane = tid & 63, r = lane & 31, h = lane >> 5;
    const int head = kvh * 4 + hp * 2 + (wave >> 2);
    const int tq = qb * 128 + (wave & 3) * 32 + r;
    u16* Q = (u16*)(p.ws + WS_Q);
    const u16* Kb = (const u16*)(p.ws + WS_K); const u16* VTb = (const u16*)(p.ws + WS_VT);
    const u16* KC = (const u16*)(p.ws + WS_KC); const u16* VCT = (const u16*)(p.ws + WS_VCT);
    bf16x8 qf[8];
    { const u16* qp = Q + ((size_t)(b * T + tq)) * D + head * 128 + 8 * h;
#pragma unroll
      for (int s = 0; s < 8; ++s) qf[s] = *(const bf16x8*)(qp + 16 * s); }
    float m_run = p.sink[head] * LOG2E; float l_run = (h == 0) ? 1.f : 0.f;
    f32x16 o[4];
#pragma unroll
    for (int mt = 0; mt < 4; ++mt)
#pragma unroll
        for (int i = 0; i < 16; ++i) o[mt][i] = 0.f;
    const int jb = (qb == 0) ? 2 : 0, je = (qb == 31) ? 4 : 6, nw = je - jb, ntile = nw + 4;
    u32x4 kreg[2], vreg[2];
#define ATT_LOAD(i) do { const int _i = (i); const u16* ks; const u16* vs; size_t vld; \
        if (_i < nw) { const int key0 = qb * 128 - 128 + 64 * (jb + _i); ks = Kb + ((size_t)(b * T + key0)) * 512 + kvh * 128; vs = VTb + ((size_t)((b * 4 + kvh) * 128)) * T + key0; vld = T; } \
        else { const int key0 = 64 * (_i - nw); ks = KC + ((size_t)(b * LC + key0)) * 512 + kvh * 128; vs = VCT + ((size_t)((b * 4 + kvh) * 128)) * LC + key0; vld = LC; } \
        _Pragma("unroll") for (int _j = 0; _j < 2; ++_j) { const int ch = tid + 512 * _j; \
            kreg[_j] = *(const u32x4*)(ks + (size_t)(ch >> 4) * 512 + (ch & 15) * 8); \
            vreg[_j] = *(const u32x4*)(vs + (size_t)(ch >> 3) * vld + (ch & 7) * 8); } } while (0)
#define ATT_STORE(bufi) do { LAS u16* kt = (LAS u16*)(lds + (bufi) * ATT_BUF); LAS u16* vt = kt + 64 * AK_LD; \
        _Pragma("unroll") for (int _j = 0; _j < 2; ++_j) { const int ch = tid + 512 * _j; \
            *(LAS u32x4*)(kt + (ch >> 4) * AK_LD + (ch & 15) * 8) = kreg[_j]; \
            LAS u16* vrow = vt + (ch >> 3) * AV_LD + ((ch & 7) >> 1) * 16 + ((ch & 1) ? 4 : 0);     \
            *(LAS u32x2*)vrow = (u32x2){vreg[_j].x, vreg[_j].y}; *(LAS u32x2*)(vrow + 8) = (u32x2){vreg[_j].z, vreg[_j].w}; } } while (0)
    ATT_LOAD(0); ATT_STORE(0);
    __syncthreads();
    for (int it = 0; it < ntile; ++it) {
        if (it + 1 < ntile) ATT_LOAD(it + 1);
        const LAS u16* kt = (const LAS u16*)(lds + (it & 1) * ATT_BUF); const LAS u16* vt = kt + 64 * AK_LD;
        int cls = 2; int key0 = 0;
        if (it < nw) { key0 = qb * 128 - 128 + 64 * (jb + it); const int q0 = qb * 128 + (wave & 3) * 32;
            if (key0 + 63 < q0 - 128 || key0 > q0 + 31 + 128) cls = 0;
            else if (key0 < q0 + 31 - 128 || key0 + 63 > q0 + 128) cls = 1; }
        if (cls != 0) {
        f32x16 sa[2];
        __builtin_amdgcn_s_setprio(1);
#pragma unroll
        for (int k2 = 0; k2 < 2; ++k2) {
#pragma unroll
            for (int i = 0; i < 16; ++i) sa[k2][i] = 0.f;
#pragma unroll
            for (int s = 0; s < 8; ++s) { const bf16x8 kf = *(const LAS bf16x8*)(kt + (32 * k2 + r) * AK_LD + 16 * s + 8 * h); sa[k2] = MFMA32(kf, qf[s], sa[k2]); }
        }
        __builtin_amdgcn_s_setprio(0);
        if (cls == 1) {
#pragma unroll
            for (int k2 = 0; k2 < 2; ++k2)
#pragma unroll
                for (int i = 0; i < 16; ++i) { const int dk = tq - (key0 + 32 * k2 + crow(i, h)); if (dk > 128 || dk < -128) sa[k2][i] = -INFINITY; }
        }
        float tmax = sa[0][0];
#pragma unroll
        for (int k2 = 0; k2 < 2; ++k2)
#pragma unroll
            for (int i = 0; i < 16; ++i) tmax = fmaxf(tmax, sa[k2][i]);
        tmax = fmaxf(tmax, __shfl_xor(tmax, 32));
        if (__builtin_amdgcn_ballot_w64(tmax > m_run + 8.f) != 0ull) {
            const float m_new = fmaxf(m_run, tmax); const float alpha = fexp2(m_run - m_new); m_run = m_new;
            l_run *= alpha;
#pragma unroll
            for (int mt = 0; mt < 4; ++mt)
#pragma unroll
                for (int i = 0; i < 16; ++i) o[mt][i] *= alpha;
        }
        float lsum = 0.f;
#pragma unroll
        for (int k2 = 0; k2 < 2; ++k2)
#pragma unroll
            for (int i = 0; i < 16; ++i) { const float pe = fexp2(sa[k2][i] - m_run); sa[k2][i] = pe; lsum += pe; }
        l_run += lsum;
        __builtin_amdgcn_s_setprio(1);
#pragma unroll
        for (int k2 = 0; k2 < 2; ++k2)
#pragma unroll
            for (int s2 = 0; s2 < 2; ++s2) {
                u32x4 pk; pk.x = pk2(sa[k2][8 * s2 + 0], sa[k2][8 * s2 + 1]); pk.y = pk2(sa[k2][8 * s2 + 2], sa[k2][8 * s2 + 3]);
                pk.z = pk2(sa[k2][8 * s2 + 4], sa[k2][8 * s2 + 5]); pk.w = pk2(sa[k2][8 * s2 + 6], sa[k2][8 * s2 + 7]);
                const bf16x8 pf = __builtin_bit_cast(bf16x8, pk);
#pragma unroll
                for (int mt = 0; mt < 4; ++mt) {
                    const u32x4 vv = *(const LAS u32x4*)(vt + (32 * mt + r) * AV_LD + 32 * k2 + 16 * s2 + 8 * h);
                    o[mt] = MFMA32(__builtin_bit_cast(bf16x8, vv), pf, o[mt]);
                }
            }
        __builtin_amdgcn_s_setprio(0);
        }
        if (it + 1 < ntile) ATT_STORE((it + 1) & 1);
        __syncthreads();
    }
    const float ltot = l_run + __shfl_xor(l_run, 32); const float inv = 1.f / ltot;
    u16* op = Q + ((size_t)(b * T + tq)) * D + head * 128;
#pragma unroll
    for (int mt = 0; mt < 4; ++mt)
#pragma unroll
        for (int q4 = 0; q4 < 4; ++q4) {
            u32x2 w; w.x = pk2(o[mt][4 * q4 + 0] * inv, o[mt][4 * q4 + 1] * inv); w.y = pk2(o[mt][4 * q4 + 2] * inv, o[mt][4 * q4 + 3] * inv);
            *(u32x2*)(op + 32 * mt + 8 * q4 + 4 * h) = w;
        }
#undef ATT_LOAD
#undef ATT_STORE
}

constexpr int HG_QH_LD = 136, HG_LD = 40;
constexpr int HG_OFF_QH = 0, HG_OFF_KHT = 32 * HG_QH_LD * 2, HG_OFF_VT = HG_OFF_KHT + 128 * HG_LD * 2, HG_OFF_AP = HG_OFF_VT + 128 * HG_LD * 2, HG_OFF_DEC = HG_OFF_AP + 4 * 32 * HG_LD * 2;
constexpr int HG_BUF = HG_OFF_DEC + 512;
constexpr int HG_PRIV = 2 * HG_BUF;
constexpr int NSTEP = 8 + 128;
constexpr int HG_RAW = HG_PRIV + 4 * 2 * 32 * HG_LD * 2, HG_RAW_A = 33 * 64, HG_RAW_W = 3 * HG_RAW_A;
static_assert(HG_RAW + 4 * HG_RAW_W <= LDS_BYTES, "hgrn lds");

__device__ __forceinline__ void hgrn_unit(const Params& p, LAS unsigned char* lds, int unit, int tid) {
    const int dir = unit & 1, hh = (unit >> 1) & 15, b = unit >> 5;
    const int wave = tid >> 6, lane = tid & 63, r = lane & 31, h = lane >> 5;
    const u16* LF = (const u16*)(p.ws + (dir ? WS_LFB : WS_LFF)); const u16* CLF = (const u16*)(p.ws + (dir ? WS_CFB : WS_CFF));
    const u16* QHg = (const u16*)(p.ws + WS_QH); const u16* VHg = (const u16*)(p.ws + WS_VH); const u16* CIg = (const u16*)(p.ws + WS_CI);
    u16* OUTg = (u16*)(p.ws + (dir ? WS_LFB : WS_LFF));
    if (wave >= 4) {
        const int pw = wave - 4;
        LAS u16* QTp = (LAS u16*)(lds + HG_PRIV + pw * (2 * 32 * HG_LD * 2)); LAS u16* KHp = QTp + 32 * HG_LD;
        LAS unsigned char* RAW = lds + HG_RAW + pw * HG_RAW_W;
        const int li = lane >> 2, lc4 = lane & 3;
        const int gcol = hh * 128 + 32 * pw + 8 * lc4;
        u32x4 R0[6], R1[6];
#define HG_LOAD(RS, s) do { const int _s = ((s) < NSTEP) ? (s) : (NSTEP - 1); const bool _ctx = _s < 8; const int _cc = _ctx ? _s : _s - 8; const int _TL = _ctx ? LC : T; \
        const u16* _lf = _ctx ? CLF : LF; const u16* _vs = _ctx ? CIg : VHg; const u16* _qs = _ctx ? CIg : QHg; const unsigned _qm = _ctx ? 0u : 0xffffffffu; \
        _Pragma("unroll") for (int jj = 0; jj < 2; ++jj) { const int pos = 32 * _cc + li + 16 * jj; const int t = dir ? (_TL - 1 - pos) : pos; const size_t idx = ((size_t)(b * _TL + t)) * D + gcol; \
            RS[jj] = *(const u32x4*)(_lf + idx); RS[2 + jj] = *(const u32x4*)(_vs + idx); const u32x4 _q = *(const u32x4*)(_qs + idx); RS[4 + jj] = (u32x4){_q.x & _qm, _q.y & _qm, _q.z & _qm, _q.w & _qm}; } } while (0)
#define HG_BUILD(RS, s) do { const int _sb = (s); \
        LAS unsigned char* buf = lds + (_sb & 1) * HG_BUF; \
        _Pragma("unroll") for (int jj = 0; jj < 2; ++jj) { const int ro = (li + 16 * jj) * 64 + jj * 64 + lc4 * 16; \
            *(LAS u32x4*)(RAW + ro) = RS[jj]; *(LAS u32x4*)(RAW + HG_RAW_A + ro) = RS[2 + jj]; *(LAS u32x4*)(RAW + 2 * HG_RAW_A + ro) = RS[4 + jj]; } \
        LDS_WAIT(); \
        HG_LOAD(RS, _sb + 2); \
        float kkv[16], P[16]; u16 qv[16], vv[16]; float run = 1.f; \
        _Pragma("unroll") for (int ii = 0; ii < 16; ++ii) { const int ro = (16 * h + ii) * 64 + h * 64 + 2 * r; \
            kkv[ii] = h2f(*(const LAS u16*)(RAW + ro)); vv[ii] = *(const LAS u16*)(RAW + HG_RAW_A + ro); qv[ii] = *(const LAS u16*)(RAW + 2 * HG_RAW_A + ro); } \
        _Pragma("unroll") for (int ii = 0; ii < 16; ++ii) { run *= (1.f - kkv[ii]); P[ii] = run; } \
        const float oth = __shfl_xor(run, 32); const float Et = run * oth; const float invE = __builtin_amdgcn_rcpf(Et); \
        const float preoff = h ? oth : 1.f; const float sufoff = h ? 1.f : oth; \
        unsigned khp[8], vpk[8]; float suf = sufoff; \
        _Pragma("unroll") for (int ii = 15; ii >= 0; --ii) { \
            const float q = bf2f(qv[ii]); const float qhv = q * (P[ii] * preoff); const float khv = kkv[ii] * suf; const float qtv = qhv * invE; \
            suf *= (1.f - kkv[ii]); \
            const int i = 16 * h + ii; \
            ((LAS u16*)(buf + HG_OFF_QH))[i * HG_QH_LD + 32 * pw + r] = (u16)(pk2(qhv, 0.f) & 0xffffu); \
            QTp[i * HG_LD + r] = (u16)(pk2(qtv, 0.f) & 0xffffu); \
            const unsigned kb = pk2(khv, 0.f) & 0xffffu; \
            KHp[i * HG_LD + r] = (u16)kb; \
            if (ii & 1) { khp[ii >> 1] = kb << 16; vpk[ii >> 1] = ((unsigned)vv[ii]) << 16; } else { khp[ii >> 1] |= kb; vpk[ii >> 1] |= (unsigned)vv[ii]; } } \
        { LAS u32x4* kd = (LAS u32x4*)((LAS u16*)(buf + HG_OFF_KHT) + (32 * pw + r) * HG_LD + 16 * h); \
          kd[0] = (u32x4){khp[0], khp[1], khp[2], khp[3]}; kd[1] = (u32x4){khp[4], khp[5], khp[6], khp[7]}; \
          LAS u32x4* vd = (LAS u32x4*)((LAS u16*)(buf + HG_OFF_VT) + (32 * pw + r) * HG_LD + 16 * h); \
          vd[0] = (u32x4){vpk[0], vpk[1], vpk[2], vpk[3]}; vd[1] = (u32x4){vpk[4], vpk[5], vpk[6], vpk[7]}; \
          if (h == 0) ((LAS float*)(buf + HG_OFF_DEC))[32 * pw + r] = Et; } \
        LDS_WAIT(); \
        f32x16 a; \
        _Pragma("unroll") for (int i = 0; i < 16; ++i) a[i] = 0.f; \
        _Pragma("unroll") for (int s2 = 0; s2 < 2; ++s2) { const bf16x8 af = *(const LAS bf16x8*)(KHp + r * HG_LD + 16 * s2 + 8 * h); const bf16x8 bfg = *(const LAS bf16x8*)(QTp + r * HG_LD + 16 * s2 + 8 * h); a = MFMA32(af, bfg, a); } \
        LAS u16* ap = (LAS u16*)(buf + HG_OFF_AP) + (pw * 32 + r) * HG_LD; \
        _Pragma("unroll") for (int q4 = 0; q4 < 4; ++q4) { float w[4]; \
            _Pragma("unroll") for (int e = 0; e < 4; ++e) { const int j = 8 * q4 + 4 * h + e; w[e] = (j <= r) ? a[4 * q4 + e] : 0.f; } \
            *(LAS u32x2*)(ap + 8 * q4 + 4 * h) = (u32x2){pk2(w[0], w[1]), pk2(w[2], w[3])}; } } while (0)
        HG_LOAD(R0, 0); HG_LOAD(R1, 1);
        for (int s = 0; s < NSTEP; s += 2) {
            HG_BUILD(R0, s);
            BAR_LDS();
            HG_BUILD(R1, s + 1);
            BAR_LDS();
        }
        BAR_LDS();
#undef HG_LOAD
#undef HG_BUILD
    } else {
        const int n = wave;
        __builtin_amdgcn_s_setprio(1);
        f32x16 S[4];
#pragma unroll
        for (int kt = 0; kt < 4; ++kt)
#pragma unroll
            for (int i = 0; i < 16; ++i) S[kt][i] = 0.f;
        for (int s = 0; s <= NSTEP; ++s) {
            if (s >= 1) {
                const int cs = s - 1;
                const LAS unsigned char* buf = lds + (cs & 1) * HG_BUF;
                const LAS u16* QHs = (const LAS u16*)(buf + HG_OFF_QH); const LAS u16* KHT = (const LAS u16*)(buf + HG_OFF_KHT);
                const LAS u16* VTs = (const LAS u16*)(buf + HG_OFF_VT); const LAS u16* AP = (const LAS u16*)(buf + HG_OFF_AP); const LAS float* DEC = (const LAS float*)(buf + HG_OFF_DEC);
                bf16x8 vf[2], ka[4][2];
#pragma unroll
                for (int s2 = 0; s2 < 2; ++s2) vf[s2] = *(const LAS bf16x8*)(VTs + (32 * n + r) * HG_LD + 16 * s2 + 8 * h);
                if (cs >= 8) {
                    bf16x8 qa[4][2], apf[4][2], sp[4][2];
#pragma unroll
                    for (int kt = 0; kt < 4; ++kt)
#pragma unroll
                        for (int s2 = 0; s2 < 2; ++s2) {
                            const LAS u16* qp = QHs + r * HG_QH_LD + 32 * kt + 16 * s2 + 4 * h;
                            const u32x2 lo = *(const LAS u32x2*)qp, hi = *(const LAS u32x2*)(qp + 8);
                            const u32x4 q4v = {lo.x, lo.y, hi.x, hi.y};
                            qa[kt][s2] = __builtin_bit_cast(bf16x8, q4v);
                            apf[kt][s2] = *(const LAS bf16x8*)(AP + (kt * 32 + r) * HG_LD + 16 * s2 + 8 * h);
                        }
#pragma unroll
                    for (int kt = 0; kt < 4; ++kt)
#pragma unroll
                        for (int s2 = 0; s2 < 2; ++s2) {
                            u32x4 spk; spk.x = pk2(S[kt][8 * s2 + 0], S[kt][8 * s2 + 1]); spk.y = pk2(S[kt][8 * s2 + 2], S[kt][8 * s2 + 3]);
                            spk.z = pk2(S[kt][8 * s2 + 4], S[kt][8 * s2 + 5]); spk.w = pk2(S[kt][8 * s2 + 6], S[kt][8 * s2 + 7]);
                            sp[kt][s2] = __builtin_bit_cast(bf16x8, spk);
                        }
                    f32x16 o1, o2;
#pragma unroll
                    for (int i = 0; i < 16; ++i) { o1[i] = 0.f; o2[i] = 0.f; }
#pragma unroll
                    for (int kt = 0; kt < 4; ++kt)
#pragma unroll
                        for (int s2 = 0; s2 < 2; ++s2) { o1 = MFMA32(qa[kt][s2], sp[kt][s2], o1); o2 = MFMA32(apf[kt][s2], vf[s2], o2); }
#pragma unroll
                    for (int kt = 0; kt < 4; ++kt)
#pragma unroll
                        for (int s2 = 0; s2 < 2; ++s2) ka[kt][s2] = *(const LAS bf16x8*)(KHT + (32 * kt + r) * HG_LD + 16 * s2 + 8 * h);
#pragma unroll
                    for (int kt = 0; kt < 4; ++kt) {
#pragma unroll
                        for (int q4 = 0; q4 < 4; ++q4) { const f32x4 d4 = *(const LAS f32x4*)(DEC + 32 * kt + 8 * q4 + 4 * h);
                            S[kt][4 * q4 + 0] *= d4.x; S[kt][4 * q4 + 1] *= d4.y; S[kt][4 * q4 + 2] *= d4.z; S[kt][4 * q4 + 3] *= d4.w; }
#pragma unroll
                        for (int s2 = 0; s2 < 2; ++s2) S[kt] = MFMA32(ka[kt][s2], vf[s2], S[kt]);
                    }
                    const int cc = cs - 8;
                    if (dir) {
                        u16* ob = OUTg + ((size_t)(b * T + (T - 1 - 32 * cc - 4 * h))) * D + hh * 128 + 32 * n + r;
#pragma unroll
                        for (int i = 0; i < 16; ++i) ob[-(ptrdiff_t)(((i & 3) + 8 * (i >> 2)) * D)] = (u16)(pkh2(o1[i] + o2[i], 0.f) & 0xffffu);
                    } else {
                        u16* of = OUTg + ((size_t)(b * T + 32 * cc + 4 * h)) * D + hh * 128 + 32 * n + r;
#pragma unroll
                        for (int i = 0; i < 16; ++i) of[(size_t)(((i & 3) + 8 * (i >> 2)) * D)] = (u16)(pkh2(o1[i] + o2[i], 0.f) & 0xffffu);
                    }
                } else {
#pragma unroll
                    for (int kt = 0; kt < 4; ++kt)
#pragma unroll
                        for (int s2 = 0; s2 < 2; ++s2) ka[kt][s2] = *(const LAS bf16x8*)(KHT + (32 * kt + r) * HG_LD + 16 * s2 + 8 * h);
#pragma unroll
                    for (int kt = 0; kt < 4; ++kt) {
#pragma unroll
                        for (int q4 = 0; q4 < 4; ++q4) { const f32x4 d4 = *(const LAS f32x4*)(DEC + 32 * kt + 8 * q4 + 4 * h);
                            S[kt][4 * q4 + 0] *= d4.x; S[kt][4 * q4 + 1] *= d4.y; S[kt][4 * q4 + 2] *= d4.z; S[kt][4 * q4 + 3] *= d4.w; }
#pragma unroll
                        for (int s2 = 0; s2 < 2; ++s2) S[kt] = MFMA32(ka[kt][s2], vf[s2], S[kt]);
                    }
                }
            }
            BAR_LDS();
        }
        __builtin_amdgcn_s_setprio(0);
    }
}

__device__ __forceinline__ void phase3b(const Params& p, int gw, int NGW, int lane) {
    const u16* OFh = (const u16*)(p.ws + WS_LFF); const u16* OBh = (const u16*)(p.ws + WS_LFB); u16* OB = (u16*)(p.ws + WS_OB);
    for (int row = gw; row < M; row += NGW) {
#pragma unroll
        for (int j = 0; j < 4; ++j) {
            const int c = 512 * j + 8 * lane; const size_t idx = (size_t)row * D + c;
            const u32x4 aa = *(const u32x4*)(OFh + idx); const u32x4 bb = *(const u32x4*)(OBh + idx);
            float v[8];
#pragma unroll
            for (int e = 0; e < 4; ++e) { const unsigned ua = aa[e], ub = bb[e];
                v[2 * e] = h2f((u16)(ua & 0xffffu)) + h2f((u16)(ub & 0xffffu)); v[2 * e + 1] = h2f((u16)(ua >> 16)) + h2f((u16)(ub >> 16)); }
            float ss = 0.f;
#pragma unroll
            for (int e = 0; e < 8; ++e) ss += v[e] * v[e];
            ss += __shfl_xor(ss, 1); ss += __shfl_xor(ss, 2); ss += __shfl_xor(ss, 4); ss += __shfl_xor(ss, 8);
            const float rstd = __builtin_amdgcn_rsqf(ss * (1.f / 128.f) + EPS);
            const f32x4 g0 = *(const f32x4*)(p.hg_gain + c), g1 = *(const f32x4*)(p.hg_gain + c + 4);
            v[0] *= rstd * g0.x; v[1] *= rstd * g0.y; v[2] *= rstd * g0.z; v[3] *= rstd * g0.w; v[4] *= rstd * g1.x; v[5] *= rstd * g1.y; v[6] *= rstd * g1.z; v[7] *= rstd * g1.w;
            *(u32x4*)(OB + idx) = pack8(v);
        }
    }
}

__device__ __forceinline__ void phase7(const Params& p, int gw, int NGW, int lane) {
    const float* rss = (const float*)(p.ws + WS_RSS);
    f32x4 g[8];
#pragma unroll
    for (int j = 0; j < 8; ++j) g[j] = *((const f32x4*)p.fgain + lane + 64 * j);
    for (int row = gw; row < M; row += 2 * NGW) {
        const int row2 = row + NGW; const bool has2 = row2 < M;
        f32x4* o1 = (f32x4*)(p.out + (size_t)row * D) + lane; f32x4* o2 = (f32x4*)(p.out + (size_t)(has2 ? row2 : row) * D) + lane;
        f32x4 v1[8], v2[8];
#pragma unroll
        for (int j = 0; j < 8; ++j) { v1[j] = o1[64 * j]; v2[j] = o2[64 * j]; }
        const float r1 = __builtin_amdgcn_rsqf(rss[row] * (1.f / D) + EPS), r2 = __builtin_amdgcn_rsqf(rss[has2 ? row2 : row] * (1.f / D) + EPS);
#pragma unroll
        for (int j = 0; j < 8; ++j) o1[64 * j] = v1[j] * r1 * g[j];
        if (has2) {
#pragma unroll
            for (int j = 0; j < 8; ++j) o2[64 * j] = v2[j] * r2 * g[j];
        }
    }
}

#define XB_TMO      128
#define XB_XCNT(j)  (256  + 64 * (j))
#define XB_XSUB(j)  (1280 + 64 * (j))
#define XB_XGEN(j)  (2304 + 64 * (j))
#define XB_TOP      3328
#define XB_TOPGEN   3392
#define XCD_BAR_WORDS 3456
#define XB_SPIN_CAP (1u << 18)
__device__ __forceinline__ unsigned xb_ld(unsigned* p)              { return __hip_atomic_load(p, __ATOMIC_RELAXED, __HIP_MEMORY_SCOPE_AGENT); }
__device__ __forceinline__ unsigned xb_add(unsigned* p, unsigned v) { return __hip_atomic_fetch_add(p, v, __ATOMIC_RELAXED, __HIP_MEMORY_SCOPE_AGENT); }
__device__ __forceinline__ unsigned xb_xcc_id() { return (unsigned)__builtin_amdgcn_s_getreg((3 << 11) | 20) & 0xFu; }
#define XB_SPIN(cond, bar) do { unsigned _sp = 0; while (cond) { __builtin_amdgcn_s_sleep(1); \
    if ((++_sp & 255u) == 0u) { if (xb_ld(&(bar)[XB_TMO])) break; if (_sp > XB_SPIN_CAP) { atomicAdd(&(bar)[XB_TMO], 1u); break; } } } } while (0)
struct XcdBarrier { unsigned* bar; unsigned x; volatile LAS unsigned* st; };
__device__ __forceinline__ XcdBarrier xcd_barrier_post(unsigned* bar, volatile LAS unsigned* st) {
    XcdBarrier b; b.bar = bar; b.x = xb_xcc_id(); b.st = st;
    if (threadIdx.x == 0) (void)xb_add(&bar[XB_XCNT(b.x)], 1u);
    return b;
}
__device__ __forceinline__ void xcd_barrier_complete(unsigned* bar, unsigned x, unsigned& nloc, unsigned& nx) {
    const unsigned G = gridDim.x * gridDim.y * gridDim.z;
    unsigned sum, cnt, mine, sp = 0u;
    for (;;) {
        sum = 0u; cnt = 0u; mine = 0u;
#pragma unroll
        for (unsigned j = 0; j < 16; ++j) { const unsigned c = xb_ld(&bar[XB_XCNT(j)]); sum += c; cnt += (c > 0u) ? 1u : 0u; mine = (j == x) ? c : mine; }
        if (sum == G) break;
        __builtin_amdgcn_s_sleep(1);
        if ((++sp & 255u) == 0u) { if (xb_ld(&bar[XB_TMO])) break; if (sp > XB_SPIN_CAP) { atomicAdd(&bar[XB_TMO], 1u); break; } }
    }
    nloc = mine > 0u ? mine : 1u; nx = cnt > 0u ? cnt : 1u;
}
__device__ __forceinline__ void xcd_barrier(const XcdBarrier& b) {
    asm volatile("s_waitcnt vmcnt(0)" ::: "memory");
    __syncthreads();
    if (threadIdx.x == 0) {
        unsigned* bar = b.bar;
        __builtin_amdgcn_s_waitcnt(0);
        unsigned nloc = b.st[0], nx = b.st[1];
        if (nloc == 0u) { xcd_barrier_complete(bar, b.x, nloc, nx); b.st[0] = nloc; b.st[1] = nx; }
        const unsigned old = xb_add(&bar[XB_XSUB(b.x)], 1u);
        const unsigned gen = old / nloc;
        if (old + 1u == (gen + 1u) * nloc) {
            __builtin_amdgcn_fence(__ATOMIC_RELEASE, "agent");
            asm volatile("s_waitcnt vmcnt(0)" ::: "memory");
            const unsigned og = xb_add(&bar[XB_TOP], 1u);
            const unsigned tg = og / nx;
            if (og + 1u == (tg + 1u) * nx) xb_add(&bar[XB_TOPGEN], 1u);
            else XB_SPIN(xb_ld(&bar[XB_TOPGEN]) == tg, bar);
            __builtin_amdgcn_fence(__ATOMIC_ACQUIRE, "agent");
            xb_add(&bar[XB_XGEN(b.x)], 1u);
            asm volatile("s_waitcnt vmcnt(0)" ::: "memory");
        } else {
            XB_SPIN(xb_ld(&bar[XB_XGEN(b.x)]) == gen, bar);
            __builtin_amdgcn_fence(__ATOMIC_ACQUIRE, "agent");
            asm volatile("s_waitcnt vmcnt(0)" ::: "memory");
        }
    }
    __syncthreads();
}

__global__ void __launch_bounds__(NTHREADS, 2) mega(Params p) {
    extern __shared__ __attribute__((aligned(16))) unsigned char lds_raw[];
    LAS unsigned char* lds = (LAS unsigned char*)lds_raw;
    cg::grid_group grid = cg::this_grid();
    const int tid = threadIdx.x, lane = tid & 63, wave = __builtin_amdgcn_readfirstlane(tid >> 6);
    const int G = gridDim.x, bid = blockIdx.x;
    const int gw = bid * 8 + wave, NGW = G * 8;
    const int lo = p.ph_lo, hi = p.ph_hi;
#define IN(k) (lo <= (k) && (k) < hi)
#define SEAM(k) do { if (IN(k) && IN((k) + 1)) xcd_barrier(xbar); } while (0)
    for (int i = tid; i < (LDS_BYTES - LDS_CTL) / 4; i += NTHREADS) ((LAS unsigned*)(lds + LDS_CTL))[i] = 0u;
    __syncthreads();
    const XcdBarrier xbar = xcd_barrier_post((unsigned*)(p.ws + WS_BAR), (volatile LAS unsigned*)(lds + LDS_CTL + 64));
    if (lo < 0) grid.sync();
    phase0_mod(p, gw, NGW, lane);
    SEAM(0);
    phase0_tr(p, lds, gw, NGW, wave, lane);
    phase1(p, gw, NGW, lane);
    SEAM(1);
    if (IN(2)) {
        pg8::Gemm g{(const u16*)(p.ws + WS_XN), (const u16*)(p.ws + WS_WINT), MTOT, N1, D};
        pg8::Order1 S{G, bid};
        EpiIn E{p.ws, p.lb_f, p.lb_b, p.b_merge, (u16*)p.out};
        pg8::gemm_phase<EpiIn, pg8::Order1>(lds, g, S, E);
    }
    SEAM(2);
    if (IN(3)) {
        if (bid < 128) { for (int u = bid; u < 128; u += (G < 128 ? G : 128)) hgrn_unit(p, lds, u, tid); }
        unsigned* qctr = (unsigned*)(p.ws + WS_QCTR);
        LAS int* sh = (LAS int*)(lds + LDS_CTL);
        int nxtq = 0;
        if (tid == 0) nxtq = (int)atomicAdd(qctr, 1u);
        for (;;) {
            if (tid == 0) sh[0] = nxtq;
            __syncthreads();
            const int pr = sh[0];
            __syncthreads();
            if (pr >= 880 + 1024) break;
            if (tid == 0) nxtq = (int)atomicAdd(qctr, 1u);
            if (pr >= 880) attn_unit(p, lds, pr - 880, tid);
            else {
                pg8::Gemm g{(const u16*)(p.ws + WS_XN), (const u16*)(p.ws + WS_WINT), MTOT, NCOL, D};
                pg8::OrderSingle S{144 + pr};
                EpiIn E{p.ws, p.lb_f, p.lb_b, p.b_merge, (u16*)p.out};
                pg8::gemm_phase<EpiIn, pg8::OrderSingle>(lds, g, S, E);
            }
        }
    }
    SEAM(3);
    if (IN(5)) {
        pg8::Gemm g{(const u16*)(p.ws + WS_XN), (const u16*)(p.ws + WS_WINT) + (size_t)N1 * D, M, 4096, D};
        pg8::StaticOrder S; S.init(M, 4096, G, bid);
        EpiGate E{p.ws, p.hg_gain, lds};
        pg8::gemm_phase<EpiGate, pg8::StaticOrder>(lds, g, S, E);
    }
    SEAM(5);
    if (IN(6)) {
        pg8::StaticOrder S; S.init(M, D, G, bid);
        { pg8::Gemm g{(const u16*)(p.ws + WS_OB), (const u16*)(p.ws + WS_WH), M, D, D}; EpiMerge<0> E{p.ws, (float*)(p.ws + WS_LFF), (const u16*)p.out}; pg8::gemm_phase<EpiMerge<0>, pg8::StaticOrder>(lds, g, S, E); }
        { pg8::Gemm g{(const u16*)(p.ws + WS_Q), (const u16*)(p.ws + WS_WA), M, D, D}; EpiMerge<1> E{p.ws, (float*)(p.ws + WS_LFF), (const u16*)p.out}; pg8::gemm_phase<EpiMerge<1>, pg8::StaticOrder>(lds, g, S, E); }
    }
    SEAM(6);
    if (IN(7)) {
        pg8::StaticOrder S; S.init(M, D, G, bid);
        pg8::Gemm g{(const u16*)(p.ws + WS_QH), (const u16*)(p.ws + WS_WO), M, D, D};
        EpiOut E{p.x, (const float*)(p.ws + WS_MOD), p.b_ada, p.out, (float*)(p.ws + WS_RSS)};
        pg8::gemm_phase<EpiOut, pg8::StaticOrder>(lds, g, S, E);
    }
    SEAM(7);
    if (IN(8)) phase7(p, gw, NGW, lane);
}

#ifndef N_LAUNCH_SPLIT
#define N_LAUNCH_SPLIT 0
#endif
extern "C" void kernel_launch(void* const* d_in, const int* in_sizes, int n_in, void* d_out, int out_size, void* d_ws, size_t ws_size, hipStream_t stream) {
    static int grid = 0;
    if (!grid) {
        int dev = 0, cus = 0, per_cu = 0;
        hipGetDevice(&dev);
        hipDeviceGetAttribute(&cus, hipDeviceAttributeMultiprocessorCount, dev);
        hipFuncSetAttribute((const void*)mega, hipFuncAttributeMaxDynamicSharedMemorySize, LDS_BYTES);
        hipOccupancyMaxActiveBlocksPerMultiprocessor(&per_cu, (const void*)mega, NTHREADS, LDS_BYTES);
        if (per_cu < 1) per_cu = 1;
        grid = cus * 1;
        if (ws_size < WS_END) { fprintf(stderr, "workspace too small: %zu < %zu\n", ws_size, (size_t)WS_END); grid = -1; }
    }
    if (grid <= 0) return;
    Params p{};
    p.x = (const float*)d_in[0]; p.c = (const float*)d_in[1]; p.ctx = (const float*)d_in[2]; p.c_ctx = (const float*)d_in[3];
    p.w_ada = (const float*)d_in[4]; p.b_ada = (const float*)d_in[5]; p.norm_gain = (const float*)d_in[6]; p.w_in = (const float*)d_in[7];
    p.b_merge = (const float*)d_in[8]; p.lb_f = (const float*)d_in[9]; p.lb_b = (const float*)d_in[10]; p.hg_gain = (const float*)d_in[11];
    p.w_o_hgrn = (const float*)d_in[12]; p.sink = (const float*)d_in[13]; p.w_o_attn = (const float*)d_in[14]; p.w_out = (const float*)d_in[15];
    p.fgain = (const float*)d_in[16];
    p.out = (float*)d_out; p.ws = (unsigned char*)d_ws;
    hipMemsetAsync(d_ws, 0, CTL_ZERO, stream);
#if N_LAUNCH_SPLIT
    for (int ph = 0; ph < 9; ++ph) { p.ph_lo = ph; p.ph_hi = ph + 1; hipLaunchKernelGGL(mega, dim3(grid), dim3(NTHREADS), LDS_BYTES, stream, p); }
#else
    p.ph_lo = 0; p.ph_hi = 9;
    void* args[] = {&p};
    hipError_t e = hipLaunchCooperativeKernel((const void*)mega, dim3(grid), dim3(NTHREADS), args, LDS_BYTES, stream);
    if (e != hipSuccess) fprintf(stderr, "cooperative launch failed: %s (grid %d)\n", hipGetErrorString(e), grid);
#endif
}
```
